# Optimizing an MI355X kernel written in HIP

```python
import jax, jax.numpy as jnp
from jax import lax
import numpy as np

D_MODEL = 2048
BATCH = 4
SEQ = 2048
DEPTH = 1
DEC_BATCH = 128
DEC_SEQ = 8
PAST_LEN = 16384
PAGE_SIZE = 128

D_RNN = D_MODEL
N_LRU_BLOCKS = 8
LRU_BLOCK = D_RNN // N_LRU_BLOCKS
CONV_W = 4
LRU_C = 8.0
N_RET_HEADS = 8
RET_DK = D_MODEL // N_RET_HEADS
RET_V_EXPAND = 2
RET_DV = RET_V_EXPAND * D_MODEL // N_RET_HEADS
QK_DIM = N_RET_HEADS * RET_DK
V_DIM = N_RET_HEADS * RET_DV
RET_CHUNK = 64
ROPE_BASE = 10000.0
D_FF = 5632
PLE_DIM = 256
EPS = 1e-6
IN_COLS = 2 * D_RNN + 2 * QK_DIM + 2 * V_DIM + 2 * D_MODEL

kernel_name = "hybrid_rglru_retention_macaron_step"


def rmsnorm(x, g):
    x32 = x.astype(jnp.float32)
    return x32 * lax.rsqrt(jnp.mean(x32 * x32, axis=-1, keepdims=True) + EPS) * g


def swiglu(u, wg, wu, wd):
    return jnp.einsum('btf,fd->btd', jax.nn.silu(jnp.einsum('btd,df->btf', u, wg)) * jnp.einsum('btd,df->btf', u, wu), wd)


def causal_conv(xb, buf, w, b):
    T = xb.shape[1]
    xp = jnp.concatenate([buf.astype(jnp.float32), xb], axis=1)
    y = b + sum(xp[:, j:j + T] * w[j] for j in range(CONV_W))
    return y, xp[:, T:]


def _lin_combine(e1, e2):
    a1, b1 = e1
    a2, b2 = e2
    return a1 * a2, a2 * b1 + b2


def rg_lru(xc, h0, wa, ba, wx, bx, lam, reset_first):
    B, T, _ = xc.shape
    xb = xc.reshape(B, T, N_LRU_BLOCKS, LRU_BLOCK)
    r = jax.nn.sigmoid(jnp.einsum('btnc,ncd->btnd', xb, wa).reshape(B, T, D_RNN) + ba)
    gi = jax.nn.sigmoid(jnp.einsum('btnc,ncd->btnd', xb, wx).reshape(B, T, D_RNN) + bx)
    log_a = -LRU_C * r * jax.nn.softplus(-lam.astype(jnp.float32))
    a = jnp.exp(log_a)
    mult = jnp.sqrt(-jnp.expm1(2.0 * log_a))
    if reset_first:
        mult = mult.at[:, 0].set(1.0)
    bterm = mult * (gi * xc)
    bterm = bterm.at[:, 0].add(a[:, 0] * h0.astype(jnp.float32))
    _, h = lax.associative_scan(_lin_combine, (a, bterm), axis=1)
    return h, h[:, -1]


def rope(x, pos):
    half = x.shape[-1] // 2
    inv = ROPE_BASE ** (-jnp.arange(half, dtype=jnp.float32) / half)
    ang = pos.astype(jnp.float32)[:, None] * inv
    cos = jnp.cos(ang)[None, :, None, :]
    sin = jnp.sin(ang)[None, :, None, :]
    x1, x2 = x[..., :half], x[..., half:]
    return jnp.concatenate([x1 * cos - x2 * sin, x2 * cos + x1 * sin], axis=-1)


def retention(q, k, v, s0):
    B, T, H, _ = q.shape
    chunk = RET_CHUNK if T % RET_CHUNK == 0 else T
    nc = T // chunk

    def to_chunks(a):
        return a.reshape(B, nc, chunk, H, a.shape[-1]).transpose(1, 0, 3, 2, 4)

    log_g = jnp.log1p(-jnp.exp2(-5.0 - jnp.arange(H, dtype=jnp.float32)))
    idx = jnp.arange(chunk, dtype=jnp.float32)
    diff = idx[:, None] - idx[None, :]
    dmask = jnp.where(diff >= 0, jnp.exp(jnp.maximum(diff, 0.0)[None] * log_g[:, None, None]), 0.0)
    cross_decay = jnp.exp((idx[None] + 1.0) * log_g[:, None])[..., None]
    state_decay = jnp.exp((chunk - 1.0 - idx[None]) * log_g[:, None])[..., None]
    chunk_decay = jnp.exp(chunk * log_g)[:, None, None]

    def step(S, inp):
        qc, kc, vc = inp
        scores = jnp.einsum('bhik,bhjk->bhij', qc, kc) * dmask
        inner = jnp.einsum('bhij,bhjv->bhiv', scores, vc)
        cross = jnp.einsum('bhik,bhkv->bhiv', qc, S) * cross_decay
        S_new = S * chunk_decay + jnp.einsum('bhjk,bhjv->bhkv', kc * state_decay, vc)
        return S_new, inner + cross

    s_last, outs = lax.scan(step, s0.astype(jnp.float32), (to_chunks(q), to_chunks(k), to_chunks(v)))
    o = outs.transpose(1, 0, 3, 2, 4).reshape(B, T, H, v.shape[-1])
    return o, s_last


def decoder_layer(x, pe, h0, conv_buf, s0, pos0, reset_first, lp):
    B, T, _ = x.shape
    x = x + 0.5 * swiglu(rmsnorm(x, lp['ffn1_norm']), lp['ffn1_wg'], lp['ffn1_wu'], lp['ffn1_wd'])
    u = rmsnorm(x, lp['mix_norm'])
    z = jnp.einsum('btd,dc->btc', u, lp['w_in']) + lp['b_in']
    cuts = [D_RNN, 2 * D_RNN, 2 * D_RNN + QK_DIM, 2 * D_RNN + 2 * QK_DIM, 2 * D_RNN + 2 * QK_DIM + V_DIM,
            2 * D_RNN + 2 * QK_DIM + 2 * V_DIM, 2 * D_RNN + 2 * QK_DIM + 2 * V_DIM + D_MODEL]
    xa, ga, q, k, v, gr, gate_a, gate_b = jnp.split(z, cuts, axis=-1)
    xc, conv_new = causal_conv(xa, conv_buf, lp['conv_w'], lp['conv_b'])
    ha, h_last = rg_lru(xc, h0, lp['lru_wa'], lp['lru_ba'], lp['lru_wx'], lp['lru_bx'], lp['lru_lambda'], reset_first)
    oa = ha * jax.nn.gelu(ga)
    pos = pos0 + jnp.arange(T)
    qh = rope(q.reshape(B, T, N_RET_HEADS, RET_DK), pos)
    kh = rope(k.reshape(B, T, N_RET_HEADS, RET_DK), pos) * (RET_DK ** -0.5)
    vh = v.reshape(B, T, N_RET_HEADS, RET_DV)
    ob, s_new = retention(qh, kh, vh, s0)
    ob = rmsnorm(ob, lp['ret_norm']).reshape(B, T, V_DIM) * jax.nn.silu(gr)
    merged = (jax.nn.sigmoid(gate_a) * jnp.einsum('btc,cd->btd', oa, lp['proj_a'])
              + jax.nn.sigmoid(gate_b) * jnp.einsum('btc,cd->btd', ob, lp['proj_b']))
    x = x + jnp.einsum('btd,de->bte', merged, lp['w_out'])
    x = x + 0.5 * swiglu(rmsnorm(x, lp['ffn2_norm']), lp['ffn2_wg'], lp['ffn2_wu'], lp['ffn2_wd'])
    gate = jax.nn.sigmoid(jnp.einsum('btd,de->bte', rmsnorm(x, lp['ple_norm']), lp['ple_wg']) + lp['ple_bg'])
    x = x + gate * jnp.einsum('btp,pd->btd', pe.astype(jnp.float32), lp['ple_proj'])
    return x, h_last, conv_new, s_new


def setup_inputs(seed: int = 0) -> dict:
    key = jax.random.key(seed)
    ks = jax.random.split(key, 40)
    f32 = jnp.float32

    def w(k, shape, fan_in, scale=1.0):
        return jax.random.normal(k, shape, f32) * (scale * fan_in ** -0.5)

    def gain(k, shape):
        return 1.0 + 0.05 * jax.random.normal(k, shape, f32)

    def bias(k, shape):
        return 0.02 * jax.random.normal(k, shape, f32)

    a0 = jax.random.uniform(ks[20], (DEPTH, D_RNN), f32, minval=0.9, maxval=0.999)
    s = a0 ** (1.0 / LRU_C)
    lam = jnp.log(s) - jnp.log1p(-s)
    return {
        'x_prompt': jax.random.normal(ks[0], (BATCH, SEQ, D_MODEL), f32),
        'x_sample': jax.random.normal(ks[1], (DEC_BATCH, DEC_SEQ, D_MODEL), f32),
        'p_prompt': jax.random.normal(ks[2], (DEPTH, BATCH, SEQ, PLE_DIM), f32),
        'p_sample': jax.random.normal(ks[3], (DEPTH, DEC_BATCH, DEC_SEQ, PLE_DIM), f32),
        'state_lru': 0.5 * jax.random.normal(ks[4], (DEPTH, DEC_BATCH, D_RNN), f32),
        'state_conv': jax.random.normal(ks[5], (DEPTH, DEC_BATCH, CONV_W - 1, D_RNN), f32),
        'state_ret': 0.5 * jax.random.normal(ks[6], (DEPTH, DEC_BATCH, N_RET_HEADS, RET_DK, RET_DV), f32),
        'ffn1_norm': gain(ks[7], (DEPTH, D_MODEL)),
        'ffn1_wg': w(ks[8], (DEPTH, D_MODEL, D_FF), D_MODEL),
        'ffn1_wu': w(ks[9], (DEPTH, D_MODEL, D_FF), D_MODEL),
        'ffn1_wd': w(ks[10], (DEPTH, D_FF, D_MODEL), D_FF, 0.5),
        'mix_norm': gain(ks[11], (DEPTH, D_MODEL)),
        'w_in': w(ks[12], (DEPTH, D_MODEL, IN_COLS), D_MODEL),
        'b_in': bias(ks[13], (DEPTH, IN_COLS)),
        'conv_w': w(ks[14], (DEPTH, CONV_W, D_RNN), CONV_W),
        'conv_b': bias(ks[15], (DEPTH, D_RNN)),
        'lru_wa': w(ks[16], (DEPTH, N_LRU_BLOCKS, LRU_BLOCK, LRU_BLOCK), LRU_BLOCK),
        'lru_ba': bias(ks[17], (DEPTH, D_RNN)),
        'lru_wx': w(ks[18], (DEPTH, N_LRU_BLOCKS, LRU_BLOCK, LRU_BLOCK), LRU_BLOCK),
        'lru_bx': bias(ks[19], (DEPTH, D_RNN)),
        'lru_lambda': lam,
        'ret_norm': gain(ks[21], (DEPTH, N_RET_HEADS, RET_DV)),
        'proj_a': w(ks[22], (DEPTH, D_RNN, D_MODEL), D_RNN),
        'proj_b': w(ks[23], (DEPTH, V_DIM, D_MODEL), V_DIM),
        'w_out': w(ks[24], (DEPTH, D_MODEL, D_MODEL), D_MODEL, 0.5),
        'ffn2_norm': gain(ks[25], (DEPTH, D_MODEL)),
        'ffn2_wg': w(ks[26], (DEPTH, D_MODEL, D_FF), D_MODEL),
        'ffn2_wu': w(ks[27], (DEPTH, D_MODEL, D_FF), D_MODEL),
        'ffn2_wd': w(ks[28], (DEPTH, D_FF, D_MODEL), D_FF, 0.5),
        'ple_norm': gain(ks[29], (DEPTH, D_MODEL)),
        'ple_wg': w(ks[30], (DEPTH, D_MODEL, D_MODEL), D_MODEL),
        'ple_bg': bias(ks[31], (DEPTH, D_MODEL)),
        'ple_proj': w(ks[32], (DEPTH, PLE_DIM, D_MODEL), PLE_DIM, 0.5),
        'final_norm': gain(ks[33], (D_MODEL,)),
    }


def reference(x_prompt, x_sample, p_prompt, p_sample, state_lru, state_conv, state_ret,
              ffn1_norm, ffn1_wg, ffn1_wu, ffn1_wd, mix_norm, w_in, b_in, conv_w, conv_b,
              lru_wa, lru_ba, lru_wx, lru_bx, lru_lambda, ret_norm, proj_a, proj_b, w_out,
              ffn2_norm, ffn2_wg, ffn2_wu, ffn2_wd, ple_norm, ple_wg, ple_bg, ple_proj, final_norm):
    xp = x_prompt.astype(jnp.float32)
    xs = x_sample.astype(jnp.float32)
    bp = x_prompt.shape[0]
    lru_p, conv_p, ret_p, lru_s, conv_s, ret_s = [], [], [], [], [], []
    for i in range(DEPTH):
        lp = {
            'ffn1_norm': ffn1_norm[i], 'ffn1_wg': ffn1_wg[i], 'ffn1_wu': ffn1_wu[i], 'ffn1_wd': ffn1_wd[i],
            'mix_norm': mix_norm[i], 'w_in': w_in[i], 'b_in': b_in[i], 'conv_w': conv_w[i], 'conv_b': conv_b[i],
            'lru_wa': lru_wa[i], 'lru_ba': lru_ba[i], 'lru_wx': lru_wx[i], 'lru_bx': lru_bx[i],
            'lru_lambda': lru_lambda[i], 'ret_norm': ret_norm[i], 'proj_a': proj_a[i], 'proj_b': proj_b[i],
            'w_out': w_out[i], 'ffn2_norm': ffn2_norm[i], 'ffn2_wg': ffn2_wg[i], 'ffn2_wu': ffn2_wu[i],
            'ffn2_wd': ffn2_wd[i], 'ple_norm': ple_norm[i], 'ple_wg': ple_wg[i], 'ple_bg': ple_bg[i],
            'ple_proj': ple_proj[i],
        }
        xp, hp, cp, sp = decoder_layer(
            xp, p_prompt[i], jnp.zeros((bp, D_RNN), jnp.float32),
            jnp.zeros((bp, CONV_W - 1, D_RNN), jnp.float32),
            jnp.zeros((bp, N_RET_HEADS, RET_DK, RET_DV), jnp.float32), 0, True, lp)
        xs, hs, cs, ss = decoder_layer(xs, p_sample[i], state_lru[i], state_conv[i], state_ret[i], PAST_LEN, False, lp)
        lru_p.append(hp); conv_p.append(cp); ret_p.append(sp)
        lru_s.append(hs); conv_s.append(cs); ret_s.append(ss)
    y_prompt = rmsnorm(xp, final_norm).astype(x_prompt.dtype)
    y_sample = rmsnorm(xs, final_norm).astype(x_sample.dtype)
    new_lru_prompt = jnp.stack(lru_p).astype(state_lru.dtype)
    new_conv_prompt = jnp.stack(conv_p).astype(state_conv.dtype)
    new_ret_prompt = jnp.stack(ret_p).astype(state_ret.dtype)
    new_lru_sample = jnp.stack(lru_s).astype(state_lru.dtype)
    new_conv_sample = jnp.stack(conv_s).astype(state_conv.dtype)
    new_ret_sample = jnp.stack(ret_s).astype(state_ret.dtype)
    return (y_prompt, y_sample, new_lru_prompt, new_conv_prompt, new_ret_prompt, new_lru_sample, new_conv_sample, new_ret_sample)
```

```cpp
#include <hip/hip_runtime.h>
#include <cstdio>
#include <cstdint>

#define LAS __attribute__((address_space(3)))
#define GAS __attribute__((address_space(1)))
typedef unsigned short bf16;
typedef short bf16x8 __attribute__((ext_vector_type(8)));
typedef float f32x4 __attribute__((ext_vector_type(4)));
typedef float f32x2 __attribute__((ext_vector_type(2)));
typedef unsigned u32x4 __attribute__((ext_vector_type(4)));
typedef unsigned u32x2 __attribute__((ext_vector_type(2)));
typedef GAS unsigned gu32;

constexpr int D = 2048, FF = 5632, NIN = 20480, MP = 8192, MS = 1024, M = MP + MS, TP = 2048, NBS = 128, NH = 8, DK = 256, DV = 512, VD = 4096, PLE = 256;
constexpr float EPS = 1e-6f;
constexpr int NWAVES = 8;

constexpr size_t O_Y = 0, O_LRUP = 18874368, O_CONVP = 18882560, O_RETP = 18907136, O_LRUS = 23101440, O_CONVS = 23363584, O_RETS = 24150016, O_END = 158367744;

constexpr size_t MiB = 1u << 20;
constexpr size_t WS_CTL = 0, CTL_ZERO_BYTES = 1 * MiB;
constexpr size_t WS_W1A = 1 * MiB;
constexpr size_t WS_W1D = WS_W1A + 44 * MiB;
constexpr size_t WS_W2A = WS_W1D + 22 * MiB;
constexpr size_t WS_W2D = WS_W2A + 44 * MiB;
constexpr size_t WS_WIN = WS_W2D + 22 * MiB;
constexpr size_t WS_WPA = WS_WIN + 80 * MiB;
constexpr size_t WS_WPB = WS_WPA + 8 * MiB;
constexpr size_t WS_WOUT = WS_WPB + 16 * MiB;
constexpr size_t WS_WPG = WS_WOUT + 8 * MiB;
constexpr size_t WS_WPP = WS_WPG + 8 * MiB;
constexpr size_t WS_WLRU = WS_WPP + 1 * MiB;
constexpr size_t WS_COS = WS_WLRU + 2 * MiB;
constexpr size_t WS_SIN = WS_COS + 2 * MiB;
constexpr size_t WS_U = WS_SIN + 2 * MiB;
constexpr size_t WS_HB = WS_U + 36 * MiB;
constexpr size_t WS_X = WS_HB + 99 * MiB;
constexpr size_t WS_XA = WS_X + 72 * MiB;
constexpr size_t WS_GA = WS_XA + 72 * MiB;
constexpr size_t WS_Q = WS_GA + 36 * MiB;
constexpr size_t WS_K = WS_Q + 36 * MiB;
constexpr size_t WS_ACAT = WS_K + 36 * MiB;
constexpr size_t WS_BCAT = WS_ACAT + 64 * MiB;
constexpr size_t WS_KTD = WS_BCAT + 128 * MiB;
constexpr size_t WS_VTS = WS_KTD + 32 * MiB;
constexpr size_t WS_SG = WS_VTS + 8 * MiB;
constexpr size_t WS_SA = WS_SG + 72 * MiB;
constexpr size_t WS_SB = WS_SA + 36 * MiB;
constexpr size_t WS_XC = WS_SB + 36 * MiB;
constexpr size_t WS_AA = WS_XC + 36 * MiB;
constexpr size_t WS_BB = WS_AA + 72 * MiB;
constexpr size_t WS_HL = WS_BB + 72 * MiB;
constexpr size_t WS_PC = WS_HL + 32 * MiB;
constexpr size_t WS_AGA = WS_PC + 32 * MiB;
constexpr size_t WS_AGB = WS_AGA + 1 * MiB;
constexpr size_t WS_OA = WS_AGB + 1 * MiB;
constexpr size_t WS_UT = WS_OA + 36 * MiB;
constexpr size_t WS_OF = WS_UT + 128 * MiB;
constexpr size_t WS_OB = WS_OF + 128 * MiB;
constexpr size_t WS_TMP = WS_OB + 72 * MiB;
constexpr size_t WS_TMP2 = WS_TMP + 72 * MiB;
constexpr size_t WS_MG = WS_TMP2 + 72 * MiB;
constexpr size_t WS_PE = WS_MG + 36 * MiB;
constexpr size_t WS_U8 = WS_PE + 5 * MiB;
constexpr size_t WS_WIN8 = WS_U8 + 19 * MiB;
constexpr size_t WS_RS = WS_WIN8 + 40 * MiB;
constexpr size_t WS_END = WS_RS + 1 * MiB;

constexpr int CW_CM1 = 65536, CW_CM2 = CW_CM1 + 2 * FF, CW_CM3 = CW_CM2 + 2 * FF, CW_CM4 = CW_CM3 + NIN;
constexpr int CW_BAR = 4096;

constexpr int RING_BYTES = 131072, LDSCTL_OFF = RING_BYTES, MISC_OFF = LDSCTL_OFF + 320, XPOSE_OFF = RING_BYTES + 2048, LDS_BYTES = 147456;

#define RLX_AGENT __ATOMIC_RELAXED, __HIP_MEMORY_SCOPE_AGENT
#define LDS_WAIT() asm volatile("s_waitcnt lgkmcnt(0)" ::: "memory")
#define VM_WAIT() asm volatile("s_waitcnt vmcnt(0)" ::: "memory")
__device__ __forceinline__ unsigned f2bf(float f) { unsigned u = __builtin_bit_cast(unsigned, f); return (u + 0x7fffu + ((u >> 16) & 1u)) >> 16; }
__device__ __forceinline__ unsigned pk2(float lo, float hi) { return f2bf(lo) | (f2bf(hi) << 16); }
__device__ __forceinline__ float bflo(unsigned w) { return __builtin_bit_cast(float, w << 16); }
__device__ __forceinline__ float bfhi(unsigned w) { return __builtin_bit_cast(float, w & 0xffff0000u); }
__device__ __forceinline__ float bf1(bf16 v) { return __builtin_bit_cast(float, ((unsigned)v) << 16); }
typedef __bf16 bf16x2_t __attribute__((ext_vector_type(2)));
__device__ __forceinline__ unsigned cvt_pk_bf16(float lo, float hi) { const f32x2 v = {lo, hi}; const bf16x2_t b = __builtin_convertvector(v, bf16x2_t); return __builtin_bit_cast(unsigned, b); }
typedef int v8i __attribute__((ext_vector_type(8)));
typedef int v4i __attribute__((ext_vector_type(4)));
__device__ __forceinline__ unsigned f2fp8x4(float a, float b, float c, float d) { int w = 0; w = __builtin_amdgcn_cvt_pk_fp8_f32(a, b, w, false); w = __builtin_amdgcn_cvt_pk_fp8_f32(c, d, w, true); return (unsigned)w; }
constexpr float H8_SCALE = 8.0f;
constexpr float O8_SCALE = 8.0f;
constexpr float W8_SCALE = 64.0f;
__device__ __forceinline__ float fast_exp2(float x) { return __builtin_amdgcn_exp2f(x); }
__device__ __forceinline__ float fast_rcp(float x) { return __builtin_amdgcn_rcpf(x); }
__device__ __forceinline__ float sigmoidf_(float x) { return fast_rcp(1.0f + fast_exp2(-1.44269504089f * x)); }
__device__ __forceinline__ float siluf_(float x) { return x * sigmoidf_(x); }
__device__ __forceinline__ float gelu_tanh_(float x) { const float u = 0.7978845608028654f * (x + 0.044715f * x * x * x); return x * fast_rcp(1.0f + fast_exp2(-2.88539008178f * u)); }
#define DPPF(old, x, ctrl, rmask) __builtin_bit_cast(float, __builtin_amdgcn_update_dpp(__builtin_bit_cast(int, (float)(old)), __builtin_bit_cast(int, (float)(x)), (ctrl), (rmask), 0xf, false))
__device__ __forceinline__ float wave_sum(float v) {
    v += DPPF(0.f, v, 0xB1, 0xf); v += DPPF(0.f, v, 0x4E, 0xf); v += DPPF(0.f, v, 0x141, 0xf); v += DPPF(0.f, v, 0x140, 0xf);
    v += DPPF(0.f, v, 0x142, 0xa); v += DPPF(0.f, v, 0x143, 0xc);
    return __builtin_bit_cast(float, __builtin_amdgcn_readlane(__builtin_bit_cast(int, v), 63));
}
__device__ __forceinline__ float wave_max(float v) {
    v = fmaxf(v, DPPF(v, v, 0xB1, 0xf)); v = fmaxf(v, DPPF(v, v, 0x4E, 0xf)); v = fmaxf(v, DPPF(v, v, 0x141, 0xf)); v = fmaxf(v, DPPF(v, v, 0x140, 0xf));
    v = fmaxf(v, DPPF(v, v, 0x142, 0xa)); v = fmaxf(v, DPPF(v, v, 0x143, 0xc));
    return __builtin_bit_cast(float, __builtin_amdgcn_readlane(__builtin_bit_cast(int, v), 63));
}
__device__ __forceinline__ unsigned f2i8x4(float a, float b, float c, float d) {
    const int ia = (int)rintf(a), ib = (int)rintf(b), ic = (int)rintf(c), id = (int)rintf(d);
    return (unsigned)(ia & 255) | ((unsigned)(ib & 255) << 8) | ((unsigned)(ic & 255) << 16) | ((unsigned)id << 24); }
__device__ __forceinline__ float log2gamma(int hh) { return log1pf(-exp2f(-5.0f - (float)hh)) * 1.4426950408889634f; }

namespace pg8 {
constexpr int BM = 256, BK = 64, HALF = 128, HTB = HALF * BK * 2, STAGE_BYTES = 8 * HTB;
__host__ __device__ __forceinline__ int lds_byte(int r, int c) { const int st = (r >> 4) * 2 + (c >> 5), rr = r & 15, cc = c & 31, ob = rr * 64 + cc * 2; return st * 1024 + (ob ^ (((ob >> 9) & 1) << 5)); }
__host__ __device__ __forceinline__ void stage_rc(int b, int& R, int& C) { const int st = b / 1024, sb = b % 1024, swz = sb ^ (((sb >> 9) & 1) << 5); R = (st >> 1) * 16 + swz / 64; C = (st & 1) * 32 + (swz % 64) / 2; }
__host__ __device__ __forceinline__ int perm32(int rho) { const int n = rho >> 4, i = rho & 15; return 8 * (i >> 2) + 4 * n + (i & 3); }

struct Unit { const char* a; const char* b; int pm, pn, nt, ks; };

template <class Epi, class Sched, int MODE = 0>
__device__ __forceinline__ void gemm_phase(LAS unsigned char* lds, const int lda, const int ldb, const Sched& S, const Epi& E) {
    int tid = threadIdx.x; asm volatile("" : "+v"(tid));
    const int wid = __builtin_amdgcn_readfirstlane(tid >> 6), lane = tid & 63, wr = wid >> 2, wc = wid & 3, fr = lane & 15, fq = lane >> 4;
    unsigned voffA[2], voffB[2];
#pragma unroll
    for (int i = 0; i < 2; ++i) { int R, C; stage_rc(tid * 16 + i * 8192, R, C); const int Rb = (R & ~31) + perm32(R & 31);
        voffA[i] = (unsigned)(R * lda + C) * 2u; voffB[i] = (unsigned)(Rb * ldb + C) * 2u; }
    const size_t kstep = (size_t)(BK * 2);
    const size_t hstepA = (size_t)HALF * lda * 2, hstepB = (size_t)HALF * ldb * 2;
    const unsigned ldsw = (unsigned)wid * 1024u;
    const int aoff = lds_byte(wr * 64 + fr, fq * 8), boff = lds_byte(wc * 32 + fr, fq * 8);
#define PG8_SA(b, h) (((b) * 2 + (h)) * HTB)
#define PG8_SB(b, h) ((4 + (b) * 2 + (h)) * HTB)
#define PG8_STAGE(bufoff, gbase, voff) do { _Pragma("unroll") for (int _i = 0; _i < 2; ++_i) \
        __builtin_amdgcn_global_load_lds((const unsigned*)((const char*)(gbase) + (voff)[_i]), (LAS unsigned*)(lds + (bufoff) + ldsw + _i * 8192), 16, 0, 0); } while (0)
#define PG8_LDA(dst, b, h) do { _Pragma("unroll") for (int m = 0; m < 4; ++m) _Pragma("unroll") for (int k = 0; k < 2; ++k) dst[m][k] = *(const LAS bf16x8*)(lds + PG8_SA(b, h) + aoff + m * 2048 + k * 1024); } while (0)
#define PG8_LDB(dst, b, h) do { _Pragma("unroll") for (int n = 0; n < 2; ++n) _Pragma("unroll") for (int k = 0; k < 2; ++k) dst[n][k] = *(const LAS bf16x8*)(lds + PG8_SB(b, h) + boff + n * 2048 + k * 1024); } while (0)
#define PG8_CAT(x0, x1) __builtin_shufflevector(__builtin_bit_cast(v4i, x0), __builtin_bit_cast(v4i, x1), 0, 1, 2, 3, 4, 5, 6, 7)
#define PG8_MMA(ai, bj, At, Bt) do { __builtin_amdgcn_s_setprio(1); _Pragma("unroll") for (int m = 0; m < 4; ++m) _Pragma("unroll") for (int n = 0; n < 2; ++n) { \
        if constexpr (MODE == 1) asm volatile("v_mfma_scale_f32_16x16x128_f8f6f4 %0, %1, %2, %0, %3, %3 op_sel_hi:[0,0,0]" : "+v"(acc[ai][bj][m][n]) : "v"(PG8_CAT(Bt[n][0], Bt[n][1])), "v"(PG8_CAT(At[m][0], At[m][1])), "v"(sc8)); \
        else if constexpr (MODE == 2) { _Pragma("unroll") for (int k = 0; k < 2; ++k) acc[ai][bj][m][n] = __builtin_bit_cast(f32x4, __builtin_amdgcn_mfma_i32_16x16x64_i8(__builtin_bit_cast(v4i, Bt[n][k]), __builtin_bit_cast(v4i, At[m][k]), __builtin_bit_cast(v4i, acc[ai][bj][m][n]), 0, 0, 0)); } \
        else { _Pragma("unroll") for (int k = 0; k < 2; ++k) acc[ai][bj][m][n] = __builtin_amdgcn_mfma_f32_16x16x32_bf16(Bt[n][k], At[m][k], acc[ai][bj][m][n], 0, 0, 0); } } \
        __builtin_amdgcn_s_setprio(0); } while (0)
#define PG8_WAIT_V(n) asm volatile("s_waitcnt vmcnt(" #n ")" ::: "memory")
#define PG8_WAIT_L(n) asm volatile("s_waitcnt lgkmcnt(" #n ")" ::: "memory")
#define PG8_BAR __builtin_amdgcn_s_barrier()
#define PG8_SCHED __builtin_amdgcn_sched_barrier(0)
    Unit cur, nxt; int ui = 0;
    if (!S.next(0, cur)) return;
    [[maybe_unused]] int sc8 = 0x7F7F7F7F;
    f32x4 acc[2][2][4][2];
#pragma unroll
    for (int a = 0; a < 2; ++a)
#pragma unroll
        for (int b = 0; b < 2; ++b)
#pragma unroll
            for (int m = 0; m < 4; ++m)
#pragma unroll
                for (int n = 0; n < 2; ++n) acc[a][b][m][n] = (f32x4){0.f, 0.f, 0.f, 0.f};
    bf16x8 At[4][2], B0[2][2], B1[2][2];
    const char* cA = cur.a; const char* cB = cur.b;
    PG8_STAGE(PG8_SB(0, 0), cB, voffB); PG8_STAGE(PG8_SB(0, 1), cB + hstepB, voffB); PG8_STAGE(PG8_SA(0, 0), cA, voffA); PG8_STAGE(PG8_SA(0, 1), cA + hstepA, voffA);
    if (wr == 1) PG8_BAR;
    PG8_WAIT_V(2); PG8_BAR;
    PG8_STAGE(PG8_SB(1, 0), cB + kstep, voffB); PG8_STAGE(PG8_SA(1, 0), cA + kstep, voffA); PG8_STAGE(PG8_SB(1, 1), cB + hstepB + kstep, voffB);
    PG8_WAIT_V(6); PG8_BAR;
    for (;;) {
        const bool has_next = S.next(ui + 1, nxt);
        const char* nA = has_next ? nxt.a : cA; const char* nB = has_next ? nxt.b : cB;
        int nt = cur.nt; asm volatile("" : "+s"(nt));
        for (int t = 0; t < nt; t += 2) {
            const bool last = (t == nt - 2);
            const char* a1 = cA + (size_t)(t + 1) * kstep;
            const char* a2 = last ? nA : cA + (size_t)(t + 2) * kstep; const char* b2 = last ? nB : cB + (size_t)(t + 2) * kstep;
            const char* a3 = a2 + kstep; const char* b3 = b2 + kstep;
            PG8_LDB(B0, 0, 0); PG8_LDB(B1, 0, 1); PG8_SCHED; PG8_LDA(At, 0, 0); PG8_STAGE(PG8_SA(1, 1), a1 + hstepA, voffA);
            PG8_WAIT_V(8); PG8_WAIT_L(0); PG8_BAR; PG8_MMA(0, 0, At, B0); PG8_MMA(0, 1, At, B1); PG8_BAR; PG8_SCHED;
            PG8_LDA(At, 0, 1); PG8_STAGE(PG8_SB(0, 0), b2, voffB); PG8_STAGE(PG8_SB(0, 1), b2 + hstepB, voffB); PG8_STAGE(PG8_SA(0, 0), a2, voffA);
            PG8_WAIT_V(8); PG8_WAIT_L(0); PG8_BAR; PG8_MMA(1, 0, At, B0); PG8_MMA(1, 1, At, B1); PG8_BAR; PG8_SCHED;
            PG8_LDB(B0, 1, 0); PG8_LDB(B1, 1, 1); PG8_SCHED; PG8_LDA(At, 1, 0); PG8_STAGE(PG8_SA(0, 1), a2 + hstepA, voffA);
            PG8_WAIT_V(8); PG8_WAIT_L(0); PG8_BAR; PG8_MMA(0, 0, At, B0); PG8_MMA(0, 1, At, B1); PG8_BAR; PG8_SCHED;
            PG8_LDA(At, 1, 1); PG8_STAGE(PG8_SB(1, 0), b3, voffB); PG8_STAGE(PG8_SB(1, 1), b3 + hstepB, voffB); PG8_STAGE(PG8_SA(1, 0), a3, voffA);
            PG8_WAIT_V(8); PG8_WAIT_L(0); PG8_BAR; PG8_MMA(1, 0, At, B0); PG8_MMA(1, 1, At, B1); PG8_BAR; PG8_SCHED;
        }
        if (wr == 0) PG8_BAR;
        if constexpr (MODE == 1) asm volatile("s_nop 15\n\ts_nop 7" ::: "memory");
        E(acc, cur, wr, wc, fr, fq);
        if (!has_next) break;
#pragma unroll
        for (int a = 0; a < 2; ++a)
#pragma unroll
            for (int b = 0; b < 2; ++b)
#pragma unroll
                for (int m = 0; m < 4; ++m)
#pragma unroll
                    for (int n = 0; n < 2; ++n) acc[a][b][m][n] = (f32x4){0.f, 0.f, 0.f, 0.f};
        cur = nxt; cA = nA; cB = nB; ++ui;
        if (wr == 1) PG8_BAR;
    }
    PG8_WAIT_V(0);
    PG8_BAR;
#undef PG8_SA
#undef PG8_SB
#undef PG8_STAGE
#undef PG8_LDA
#undef PG8_LDB
#undef PG8_MMA
#undef PG8_CAT
#undef PG8_WAIT_V
#undef PG8_WAIT_L
#undef PG8_BAR
#undef PG8_SCHED
}

struct TileOrder {
    const char* A; const char* B; size_t strideA, strideB; int nM, nN, nwg, G, c, nt; int pn_s1 = 1 << 30, pn_s2 = 1 << 30, pn_a = 0, pn_b = 0, pn_c = 0;
    __device__ __forceinline__ void init(const void* A_, size_t sA, const void* B_, size_t sB, int nM_, int nN_, int nt_, int G_, int c_) { A = (const char*)A_; B = (const char*)B_; strideA = sA; strideB = sB; nM = nM_; nN = nN_; nwg = nM * nN; nt = nt_; G = G_; c = c_; }
    __device__ __forceinline__ bool next(int i, Unit& u) const {
        const int L = i * G + c; if (L >= nwg) return false;
        int wgid = L; { const int q = nwg / 8, r = nwg % 8, xcd = wgid % 8, off = wgid / 8; wgid = (xcd < r ? xcd * (q + 1) : r * (q + 1) + (xcd - r) * q) + off; }
        const int nig = 8 * nN, gid = wgid / nig, fm = gid * 8, gsz = (nM - fm) < 8 ? (nM - fm) : 8;
        u.pm = fm + ((wgid % nig) % gsz); { const int idx = (wgid % nig) / gsz; u.pn = idx < pn_s1 ? pn_a + idx : (idx < pn_s2 ? pn_b + idx - pn_s1 : pn_c + idx - pn_s2); }
        u.a = A + (size_t)u.pm * strideA; u.b = B + (size_t)u.pn * strideB; u.nt = nt; u.ks = -1; return true;
    }
};
struct SplitOrder {
    const char* A; const char* B; size_t strideA, strideB; int KT, G, c;
    __device__ __forceinline__ void init(const void* A_, size_t sA, const void* B_, size_t sB, int KT_, int G_, int c_) { A = (const char*)A_; B = (const char*)B_; strideA = sA; strideB = sB; KT = KT_; G = G_; c = c_; }
    __device__ __forceinline__ bool next(int i, Unit& u) const {
        const int L = i * G + c; if (L >= 512) return false;
        if (L < 256) { const int wgid = (L % 8) * 32 + L / 8;
            const int gid = wgid / 64, w = wgid % 64; u.pm = gid * 8 + (w % 8); u.pn = w / 8; u.nt = KT; u.ks = -1;
            u.a = A + (size_t)u.pm * strideA; u.b = B + (size_t)u.pn * strideB; return true; }
        const int sidx = L - 256, su = sidx >> 3, ks = sidx & 7; u.pm = 32 + (su & 3); u.pn = su >> 2; u.ks = ks;
        int kt0; if (KT == 88) { u.nt = (ks & 1) ? 10 : 12; kt0 = (ks >> 1) * 22 + (ks & 1) * 12; } else if (KT == 44) { u.nt = ks < 6 ? 6 : 4; kt0 = ks < 6 ? ks * 6 : 36 + (ks - 6) * 4; } else { u.nt = KT / 8; kt0 = ks * u.nt; }
        u.a = A + (size_t)u.pm * strideA + (size_t)kt0 * 128; u.b = B + (size_t)u.pn * strideB + (size_t)kt0 * 128; return true;
    }
};
}
using pg8::Unit;

#define EPI_ARGS const f32x4 (&acc)[2][2][4][2], const Unit& u, int wr, int wc, int fr, int fq
#define EPI_OPAQUE() asm volatile("" : "+v"(fr), "+v"(fq))
#define FOR_AI_M _Pragma("unroll") for (int ai = 0; ai < 2; ++ai) _Pragma("unroll") for (int m = 0; m < 4; ++m) if ((__builtin_amdgcn_sched_barrier(0), true))

struct EpiSwiglu {
    bf16* H;
    __device__ __forceinline__ void operator()(EPI_ARGS) const { EPI_OPAQUE();
        const int col0 = u.pn * 128 + wc * 32 + 8 * fq;
        FOR_AI_M { const int row = u.pm * 256 + ai * 128 + wr * 64 + m * 16 + fr;
            float o[8];
#pragma unroll
            for (int n = 0; n < 2; ++n)
#pragma unroll
                for (int j = 0; j < 4; ++j) o[4 * n + j] = siluf_(acc[ai][0][m][n][j]) * acc[ai][1][m][n][j];
            u32x4 w; w.x = cvt_pk_bf16(o[0], o[1]); w.y = cvt_pk_bf16(o[2], o[3]); w.z = cvt_pk_bf16(o[4], o[5]); w.w = cvt_pk_bf16(o[6], o[7]);
            *(u32x4*)(H + (size_t)row * FF + col0) = w; }
    }
};
struct EpiSwigluQ8 {
    unsigned char* H; const float* rs; const unsigned* cm;
    __device__ __forceinline__ void operator()(EPI_ARGS) const { EPI_OPAQUE();
        const int col0 = u.pn * 128 + wc * 32 + 8 * fq;
        float sg[8], su[8];
#pragma unroll
        for (int e = 0; e < 8; ++e) { sg[e] = __uint_as_float(cm[u.pn * 256 + wc * 32 + 8 * fq + e]) * (1.0f / 127.0f); su[e] = __uint_as_float(cm[u.pn * 256 + 128 + wc * 32 + 8 * fq + e]) * (1.0f / 127.0f); }
        float sav[2][4];
#pragma unroll
        for (int ai = 0; ai < 2; ++ai)
#pragma unroll
            for (int m = 0; m < 4; ++m) sav[ai][m] = rs[u.pm * 256 + ai * 128 + wr * 64 + m * 16 + fr];
        FOR_AI_M { const int row = u.pm * 256 + ai * 128 + wr * 64 + m * 16 + fr; const float sa = sav[ai][m];
            float o[8];
#pragma unroll
            for (int n = 0; n < 2; ++n)
#pragma unroll
                for (int j = 0; j < 4; ++j) { const float fg = acc[ai][0][m][n][j], fu = acc[ai][1][m][n][j];
                    const float g = (float)__float_as_int(fg) * (sa * sg[4 * n + j]), uu = (float)__float_as_int(fu) * (sa * su[4 * n + j]);
                    o[4 * n + j] = __builtin_amdgcn_fmed3f(siluf_(g) * uu * H8_SCALE, -440.0f, 440.0f); }
            u32x2 w; w.x = f2fp8x4(o[0], o[1], o[2], o[3]); w.y = f2fp8x4(o[4], o[5], o[6], o[7]);
            *(u32x2*)(H + (size_t)row * FF + col0) = w; }
    }
};
template <bool INBF> struct EpiResid {
    const void* inP; bf16* out; float alpha; float* slab; float accs;
    __device__ __forceinline__ void operator()(EPI_ARGS) const { EPI_OPAQUE();
        if (u.ks >= 0) {
            bf16* o = (bf16*)slab + ((size_t)u.ks * MS + (size_t)(u.pm - 32) * 256) * D;
            FOR_AI_M { const int rl = ai * 128 + wr * 64 + m * 16 + fr;
#pragma unroll
                for (int bj = 0; bj < 2; ++bj) { const size_t off = (size_t)rl * D + u.pn * 256 + bj * 128 + wc * 32 + 8 * fq; const f32x4 a0 = acc[ai][bj][m][0] * accs, a1 = acc[ai][bj][m][1] * accs;
                    u32x4 w; w.x = cvt_pk_bf16(a0[0], a0[1]); w.y = cvt_pk_bf16(a0[2], a0[3]); w.z = cvt_pk_bf16(a1[0], a1[1]); w.w = cvt_pk_bf16(a1[2], a1[3]); *(u32x4*)(o + off) = w; } }
            return; }
        bf16* o = out + (size_t)u.pm * 256 * D;
        FOR_AI_M { const int rl = ai * 128 + wr * 64 + m * 16 + fr;
#pragma unroll
            for (int bj = 0; bj < 2; ++bj) { const size_t off = (size_t)rl * D + u.pn * 256 + bj * 128 + wc * 32 + 8 * fq; f32x4 x0, x1;
                if (INBF) { const u32x4 xw = *(const u32x4*)((const bf16*)inP + (size_t)u.pm * 256 * D + off); x0 = (f32x4){bflo(xw.x), bfhi(xw.x), bflo(xw.y), bfhi(xw.y)}; x1 = (f32x4){bflo(xw.z), bfhi(xw.z), bflo(xw.w), bfhi(xw.w)}; }
                else { const float* in = (const float*)inP + (size_t)u.pm * 256 * D + off; x0 = *(const f32x4*)in; x1 = *(const f32x4*)(in + 4); }
                const f32x4 r0 = x0 + alpha * acc[ai][bj][m][0], r1 = x1 + alpha * acc[ai][bj][m][1];
                u32x4 w; w.x = cvt_pk_bf16(r0[0], r0[1]); w.y = cvt_pk_bf16(r0[2], r0[3]); w.z = cvt_pk_bf16(r1[0], r1[1]); w.w = cvt_pk_bf16(r1[2], r1[3]); *(u32x4*)(o + off) = w; } }
    }
};
#define MIXV(ai, bj, m, n, j) (Q8 ? fmaf((float)__float_as_int(acc[ai][bj][m][n][j]), sa * sw[bj][n][j], bv[bj][n][j]) : acc[ai][bj][m][n][j] + bv[bj][n][j])
template <bool Q8> struct EpiMix {
    const float* bias; const float* cosT; const float* sinT;
    bf16 *XA, *GA, *Q, *K, *ACAT, *BCAT, *KTD, *VTS, *SG, *SA, *SB; LAS unsigned char* xl; const float* rs; const unsigned* cm;
    template <int ACT> __device__ __forceinline__ void plain_bf16(EPI_ARGS, bf16* O, int ldo, int ct) const {
        f32x4 bv[2][2], sw[2][2];
#pragma unroll
        for (int bj = 0; bj < 2; ++bj)
#pragma unroll
            for (int n = 0; n < 2; ++n) { bv[bj][n] = *(const f32x4*)(bias + u.pn * 256 + bj * 128 + wc * 32 + 8 * fq + 4 * n); if (Q8) { const u32x4 cw = *(const u32x4*)(cm + u.pn * 256 + bj * 128 + wc * 32 + 8 * fq + 4 * n); sw[bj][n] = (f32x4){__uint_as_float(cw.x), __uint_as_float(cw.y), __uint_as_float(cw.z), __uint_as_float(cw.w)} * (1.0f / 127.0f); } else sw[bj][n] = (f32x4){0.f, 0.f, 0.f, 0.f}; }
        float sav[2][4];
#pragma unroll
        for (int ai = 0; ai < 2; ++ai)
#pragma unroll
            for (int m = 0; m < 4; ++m) sav[ai][m] = Q8 ? rs[u.pm * 256 + ai * 128 + wr * 64 + m * 16 + fr] : 0.f;
        FOR_AI_M { const int row = u.pm * 256 + ai * 128 + wr * 64 + m * 16 + fr; const float sa = sav[ai][m];
#pragma unroll
            for (int bj = 0; bj < 2; ++bj) { float o[8];
#pragma unroll
                for (int n = 0; n < 2; ++n)
#pragma unroll
                    for (int j = 0; j < 4; ++j) { const float v = MIXV(ai, bj, m, n, j); o[4 * n + j] = ACT == 0 ? gelu_tanh_(v) : (ACT == 1 ? siluf_(v) : (ACT == 2 ? sigmoidf_(v) : v)); }
                u32x4 w; w.x = cvt_pk_bf16(o[0], o[1]); w.y = cvt_pk_bf16(o[2], o[3]); w.z = cvt_pk_bf16(o[4], o[5]); w.w = cvt_pk_bf16(o[6], o[7]);
                *(u32x4*)(O + (size_t)row * ldo + ct * 256 + bj * 128 + wc * 32 + 8 * fq) = w; } }
    }
    __device__ __forceinline__ void operator()(EPI_ARGS) const { EPI_OPAQUE();
        const int pn = u.pn;
        if (pn < 8) { plain_bf16<3>(acc, u, wr, wc, fr, fq, XA, D, pn);
        } else if (pn < 16) { plain_bf16<0>(acc, u, wr, wc, fr, fq, GA, D, pn - 8);
        } else if (pn < 32) {
            const bool isk = pn >= 24; const int hh = (pn - 16) & 7; const float l2g = log2gamma(hh);
            const bool prompt = u.pm < 32; const float ksc = isk ? 0.0625f : 1.0f;
            f32x4 bv[2][2], sw[2][2];
#pragma unroll
            for (int bj = 0; bj < 2; ++bj)
#pragma unroll
                for (int n = 0; n < 2; ++n) { bv[bj][n] = *(const f32x4*)(bias + pn * 256 + bj * 128 + wc * 32 + 8 * fq + 4 * n); if (Q8) { const u32x4 cw = *(const u32x4*)(cm + pn * 256 + bj * 128 + wc * 32 + 8 * fq + 4 * n); sw[bj][n] = (f32x4){__uint_as_float(cw.x), __uint_as_float(cw.y), __uint_as_float(cw.z), __uint_as_float(cw.w)} * (1.0f / 127.0f); } else sw[bj][n] = (f32x4){0.f, 0.f, 0.f, 0.f}; }
            bf16* QK = isk ? K : Q;
            float sav[2][4];
#pragma unroll
        for (int ai = 0; ai < 2; ++ai)
#pragma unroll
            for (int m = 0; m < 4; ++m) sav[ai][m] = Q8 ? rs[u.pm * 256 + ai * 128 + wr * 64 + m * 16 + fr] : 0.f;
            FOR_AI_M { const int rl = ai * 128 + wr * 64 + m * 16 + fr; const float sa = sav[ai][m];
                int tp; size_t rowbase;
                int bhc = 0;
                if (prompt) { const int b = u.pm >> 3, c = u.pm & 7; tp = c * 256 + rl; bhc = (b * 8 + hh) * 8 + c; rowbase = ((size_t)bhc * 256 + rl) * 256; }
                else { const int sr = (u.pm - 32) * 256 + rl, b = sr >> 3, t = sr & 7; tp = 2048 + t; rowbase = (size_t)32 * 2048 * 256 + ((size_t)(b * 8 + hh) * 8 + t) * 256; }
                float o1[8], o2[8];
#pragma unroll
                for (int n = 0; n < 2; ++n) { const f32x4 cv = *(const f32x4*)(cosT + (size_t)tp * 128 + wc * 32 + 8 * fq + 4 * n), sv = *(const f32x4*)(sinT + (size_t)tp * 128 + wc * 32 + 8 * fq + 4 * n);
#pragma unroll
                    for (int j = 0; j < 4; ++j) { const float x1 = MIXV(ai, 0, m, n, j), x2 = MIXV(ai, 1, m, n, j);
                        o1[4 * n + j] = (x1 * cv[j] - x2 * sv[j]) * ksc; o2[4 * n + j] = (x2 * cv[j] + x1 * sv[j]) * ksc; } }
                const int dk0 = wc * 32 + 8 * fq;
                u32x4 w1, w2; w1.x = cvt_pk_bf16(o1[0], o1[1]); w1.y = cvt_pk_bf16(o1[2], o1[3]); w1.z = cvt_pk_bf16(o1[4], o1[5]); w1.w = cvt_pk_bf16(o1[6], o1[7]);
                w2.x = cvt_pk_bf16(o2[0], o2[1]); w2.y = cvt_pk_bf16(o2[2], o2[3]); w2.z = cvt_pk_bf16(o2[4], o2[5]); w2.w = cvt_pk_bf16(o2[6], o2[7]);
                *(u32x4*)(QK + rowbase + dk0) = w1; *(u32x4*)(QK + rowbase + 128 + dk0) = w2;
                if (prompt) {
                    if (!isk) {
                        const float g = fast_exp2((float)(rl + 1) * l2g); bf16* p = ACAT + ((size_t)bhc * 256 + rl) * 512 + 256 + dk0;
                        u32x4 v1, v2; v1.x = cvt_pk_bf16(o1[0] * g, o1[1] * g); v1.y = cvt_pk_bf16(o1[2] * g, o1[3] * g); v1.z = cvt_pk_bf16(o1[4] * g, o1[5] * g); v1.w = cvt_pk_bf16(o1[6] * g, o1[7] * g);
                        v2.x = cvt_pk_bf16(o2[0] * g, o2[1] * g); v2.y = cvt_pk_bf16(o2[2] * g, o2[3] * g); v2.z = cvt_pk_bf16(o2[4] * g, o2[5] * g); v2.w = cvt_pk_bf16(o2[6] * g, o2[7] * g);
                        *(u32x4*)p = v1; *(u32x4*)(p + 128) = v2;
                    } else {
                        const float g = fast_exp2((float)(255 - rl) * l2g); LAS bf16* scr = (LAS bf16*)(xl + (wr * 4 + wc) * 1024); const int ln = fr + 16 * fq;
#pragma unroll
                        for (int hf = 0; hf < 2; ++hf) {
#pragma unroll
                            for (int e = 0; e < 8; ++e) scr[(8 * fq + e) * 16 + fr] = (bf16)f2bf((hf ? o2[e] : o1[e]) * g);
                            asm volatile("" ::: "memory");
                            const u32x4 w = *(const LAS u32x4*)(scr + (ln >> 1) * 16 + (ln & 1) * 8);
                            asm volatile("" ::: "memory");
                            *(u32x4*)(KTD + ((size_t)bhc * 256 + hf * 128 + wc * 32 + (ln >> 1)) * 256 + (rl - fr) + (ln & 1) * 8) = w; }
                    }
                }
            }
        } else if (pn < 48) {
            const int hh = (pn - 32) >> 1, half = (pn - 32) & 1; const bool prompt = u.pm < 32;
            f32x4 bv[2][2], sw[2][2];
#pragma unroll
            for (int bj = 0; bj < 2; ++bj)
#pragma unroll
                for (int n = 0; n < 2; ++n) { bv[bj][n] = *(const f32x4*)(bias + pn * 256 + bj * 128 + wc * 32 + 8 * fq + 4 * n); if (Q8) { const u32x4 cw = *(const u32x4*)(cm + pn * 256 + bj * 128 + wc * 32 + 8 * fq + 4 * n); sw[bj][n] = (f32x4){__uint_as_float(cw.x), __uint_as_float(cw.y), __uint_as_float(cw.z), __uint_as_float(cw.w)} * (1.0f / 127.0f); } else sw[bj][n] = (f32x4){0.f, 0.f, 0.f, 0.f}; }
            LAS bf16* scr = (LAS bf16*)(xl + (wr * 4 + wc) * 1024); const int ln = fr + 16 * fq;
            FOR_AI_M { const int rb = ai * 128 + wr * 64 + m * 16; const float sa = Q8 ? rs[u.pm * 256 + rb + fr] : 0.f;
                bf16* p; size_t es;
                if (prompt) { const int b = u.pm >> 3, c = u.pm & 7, bhc = (b * 8 + hh) * 8 + c; p = BCAT + (size_t)bhc * 512 * 512 + rb + (ln & 1) * 8; es = 512; }
                else { const int sr = (u.pm - 32) * 256 + rb, b = (sr >> 3) + (ln & 1); p = VTS + (size_t)(b * 8 + hh) * 512 * 8; es = 8; }
#pragma unroll
                for (int bj = 0; bj < 2; ++bj) {
#pragma unroll
                    for (int n = 0; n < 2; ++n)
#pragma unroll
                        for (int j = 0; j < 4; ++j) scr[(8 * fq + 4 * n + j) * 16 + fr] = (bf16)f2bf(MIXV(ai, bj, m, n, j));
                    asm volatile("" ::: "memory");
                    const u32x4 w = *(const LAS u32x4*)(scr + (ln >> 1) * 16 + (ln & 1) * 8);
                    asm volatile("" ::: "memory");
                    *(u32x4*)(p + (size_t)(half * 256 + bj * 128 + wc * 32 + (ln >> 1)) * es) = w; }
            }
        } else if (pn < 64) { plain_bf16<1>(acc, u, wr, wc, fr, fq, SG, VD, pn - 48);
        } else { plain_bf16<2>(acc, u, wr, wc, fr, fq, pn < 72 ? SA : SB, D, (pn - 64) & 7); }
    }
};
#undef MIXV
struct EpiLru {
    const bf16* XC; const float *ba, *bx, *lam; bf16 *AA, *BB;
    __device__ __forceinline__ void operator()(EPI_ARGS) const { EPI_OPAQUE();
        const int ch0 = (u.pn >> 1) * 256 + (u.pn & 1) * 128 + wc * 32 + 8 * fq;
        float vba[8], vbx[8], vsp[8];
#pragma unroll
        for (int e = 0; e < 8; ++e) { vba[e] = ba[ch0 + e]; vbx[e] = bx[ch0 + e]; vsp[e] = log1pf(expf(-lam[ch0 + e])); }
        FOR_AI_M { const int row = u.pm * 256 + ai * 128 + wr * 64 + m * 16 + fr;
            const bool first = (row < MP) && ((row & (TP - 1)) == 0);
            const u32x4 xw = *(const u32x4*)(XC + (size_t)row * D + ch0);
            const float xc[8] = {bflo(xw.x), bfhi(xw.x), bflo(xw.y), bfhi(xw.y), bflo(xw.z), bfhi(xw.z), bflo(xw.w), bfhi(xw.w)};
            float av[8], bvv[8];
#pragma unroll
            for (int n = 0; n < 2; ++n)
#pragma unroll
                for (int j = 0; j < 4; ++j) { const int e = 4 * n + j;
                    const float r = sigmoidf_(acc[ai][0][m][n][j] + vba[e]), gi = sigmoidf_(acc[ai][1][m][n][j] + vbx[e]);
                    const float la2 = -11.5415603271f * r * vsp[e];
                    const float a = fast_exp2(la2); float mult = __builtin_amdgcn_sqrtf(fmaxf(1.0f - a * a, 0.0f)); if (first) mult = 1.0f;
                    av[e] = 1.0f - a; bvv[e] = mult * gi * xc[e]; }
            u32x4 wa, wb; wa.x = cvt_pk_bf16(av[0], av[1]); wa.y = cvt_pk_bf16(av[2], av[3]); wa.z = cvt_pk_bf16(av[4], av[5]); wa.w = cvt_pk_bf16(av[6], av[7]);
            wb.x = cvt_pk_bf16(bvv[0], bvv[1]); wb.y = cvt_pk_bf16(bvv[2], bvv[3]); wb.z = cvt_pk_bf16(bvv[4], bvv[5]); wb.w = cvt_pk_bf16(bvv[6], bvv[7]);
            *(u32x4*)(AA + (size_t)row * D + ch0) = wa; *(u32x4*)(BB + (size_t)row * D + ch0) = wb; }
    }
};
struct EpiScores {
    bf16* ACAT;
    __device__ __forceinline__ void operator()(EPI_ARGS) const { EPI_OPAQUE();
        const int bhc = u.pm, hh = (bhc >> 3) & 7; const float l2g = log2gamma(hh);
        FOR_AI_M { const int i = ai * 128 + wr * 64 + m * 16 + fr;
#pragma unroll
            for (int bj = 0; bj < 2; ++bj) { const int j0 = bj * 128 + wc * 32 + 8 * fq; float o[8];
#pragma unroll
                for (int n = 0; n < 2; ++n)
#pragma unroll
                    for (int jj = 0; jj < 4; ++jj) { const float fd = (float)(i - (j0 + 4 * n + jj)); o[4 * n + jj] = acc[ai][bj][m][n][jj] * fast_exp2(fd * l2g - fmaxf(-fd, 0.0f) * 1000.0f); }
                u32x4 w; w.x = cvt_pk_bf16(o[0], o[1]); w.y = cvt_pk_bf16(o[2], o[3]); w.z = cvt_pk_bf16(o[4], o[5]); w.w = cvt_pk_bf16(o[6], o[7]);
                *(u32x4*)(ACAT + ((size_t)bhc * 256 + i) * 512 + j0) = w; }
            __builtin_amdgcn_sched_barrier(0); }
    }
};
struct EpiUT {
    bf16* UT;
    __device__ __forceinline__ void operator()(EPI_ARGS) const { EPI_OPAQUE();
        bf16* base = UT + ((size_t)u.pm * 512 + u.pn * 256) * 256;
        FOR_AI_M { const int rl = ai * 128 + wr * 64 + m * 16 + fr;
#pragma unroll
            for (int bj = 0; bj < 2; ++bj) { const f32x4 a0 = acc[ai][bj][m][0], a1 = acc[ai][bj][m][1];
                u32x4 w; w.x = cvt_pk_bf16(a0[0], a0[1]); w.y = cvt_pk_bf16(a0[2], a0[3]); w.z = cvt_pk_bf16(a1[0], a1[1]); w.w = cvt_pk_bf16(a1[2], a1[3]);
                *(u32x4*)(base + (size_t)rl * 256 + bj * 128 + wc * 32 + 8 * fq) = w; } }
    }
};
struct EpiO {
    bf16* OF;
    __device__ __forceinline__ void operator()(EPI_ARGS) const { EPI_OPAQUE();
        const int bhc = u.pm, b = bhc >> 6, hh = (bhc >> 3) & 7, c = bhc & 7;
        bf16* base = OF + ((size_t)b * TP + c * 256) * VD + hh * 512 + u.pn * 256;
        FOR_AI_M { const int rl = ai * 128 + wr * 64 + m * 16 + fr;
#pragma unroll
            for (int bj = 0; bj < 2; ++bj) { const f32x4 a0 = acc[ai][bj][m][0], a1 = acc[ai][bj][m][1];
                u32x4 w; w.x = cvt_pk_bf16(a0[0], a0[1]); w.y = cvt_pk_bf16(a0[2], a0[3]); w.z = cvt_pk_bf16(a1[0], a1[1]); w.w = cvt_pk_bf16(a1[2], a1[3]);
                *(u32x4*)(base + (size_t)rl * VD + bj * 128 + wc * 32 + 8 * fq) = w; } }
    }
};
__device__ __forceinline__ void slab_store(EPI_ARGS, float* slab, float accs = 1.0f) {
    bf16* o = (bf16*)slab + ((size_t)u.ks * MS + (size_t)(u.pm - 32) * 256) * D;
    FOR_AI_M { const int rl = ai * 128 + wr * 64 + m * 16 + fr;
#pragma unroll
        for (int bj = 0; bj < 2; ++bj) { const size_t off = (size_t)rl * D + u.pn * 256 + bj * 128 + wc * 32 + 8 * fq; const f32x4 a0 = acc[ai][bj][m][0] * accs, a1 = acc[ai][bj][m][1] * accs;
            u32x4 w; w.x = cvt_pk_bf16(a0[0], a0[1]); w.y = cvt_pk_bf16(a0[2], a0[3]); w.z = cvt_pk_bf16(a1[0], a1[1]); w.w = cvt_pk_bf16(a1[2], a1[3]); *(u32x4*)(o + off) = w; } }
}
template <int MODE> struct EpiGate {
    const bf16* G; bf16* T; bf16* O; float* slab; float accs;
    __device__ __forceinline__ void operator()(EPI_ARGS) const { EPI_OPAQUE();
        if (u.ks >= 0) { slab_store(acc, u, wr, wc, fr, fq, slab, accs); return; }
        FOR_AI_M { const int row = u.pm * 256 + ai * 128 + wr * 64 + m * 16 + fr;
#pragma unroll
            for (int bj = 0; bj < 2; ++bj) { const size_t off = (size_t)row * D + u.pn * 256 + bj * 128 + wc * 32 + 8 * fq;
                const u32x4 gw = *(const u32x4*)(G + off);
                const f32x4 g0 = (f32x4){bflo(gw.x), bfhi(gw.x), bflo(gw.y), bfhi(gw.y)} * accs, g1 = (f32x4){bflo(gw.z), bfhi(gw.z), bflo(gw.w), bfhi(gw.w)} * accs;
                if (MODE == 0) { const f32x4 p0 = g0 * acc[ai][bj][m][0], p1 = g1 * acc[ai][bj][m][1];
                    u32x4 w; w.x = cvt_pk_bf16(p0[0], p0[1]); w.y = cvt_pk_bf16(p0[2], p0[3]); w.z = cvt_pk_bf16(p1[0], p1[1]); w.w = cvt_pk_bf16(p1[2], p1[3]); *(u32x4*)(T + off) = w; }
                else { const u32x4 tw = *(const u32x4*)(T + off);
                    const f32x4 t0 = (f32x4){bflo(tw.x), bfhi(tw.x), bflo(tw.y), bfhi(tw.y)} + g0 * acc[ai][bj][m][0], t1 = (f32x4){bflo(tw.z), bfhi(tw.z), bflo(tw.w), bfhi(tw.w)} + g1 * acc[ai][bj][m][1];
                    u32x4 w; w.x = cvt_pk_bf16(t0[0], t0[1]); w.y = cvt_pk_bf16(t0[2], t0[3]); w.z = cvt_pk_bf16(t1[0], t1[1]); w.w = cvt_pk_bf16(t1[2], t1[3]);
                    *(u32x4*)(O + off) = w; } } }
    }
};
struct EpiStoreF32 {
    bf16* T;
    __device__ __forceinline__ void operator()(EPI_ARGS) const { EPI_OPAQUE();
        FOR_AI_M { const int row = u.pm * 256 + ai * 128 + wr * 64 + m * 16 + fr;
#pragma unroll
            for (int bj = 0; bj < 2; ++bj) { const f32x4 a0 = acc[ai][bj][m][0], a1 = acc[ai][bj][m][1];
                u32x4 w; w.x = cvt_pk_bf16(a0[0], a0[1]); w.y = cvt_pk_bf16(a0[2], a0[3]); w.z = cvt_pk_bf16(a1[0], a1[1]); w.w = cvt_pk_bf16(a1[2], a1[3]);
                *(u32x4*)(T + (size_t)row * D + u.pn * 256 + bj * 128 + wc * 32 + 8 * fq) = w; } }
    }
};
struct EpiPle {
    const float* bg; const bf16* T; bf16* X; float* slab; const float* rs; const unsigned* cm;
    __device__ __forceinline__ void operator()(EPI_ARGS) const { EPI_OPAQUE();
        f32x4 bv[2][2], sw[2][2];
#pragma unroll
        for (int bj = 0; bj < 2; ++bj)
#pragma unroll
            for (int n = 0; n < 2; ++n) { bv[bj][n] = *(const f32x4*)(bg + u.pn * 256 + bj * 128 + wc * 32 + 8 * fq + 4 * n); const u32x4 cw = *(const u32x4*)(cm + u.pn * 256 + bj * 128 + wc * 32 + 8 * fq + 4 * n);
                sw[bj][n] = (f32x4){__uint_as_float(cw.x), __uint_as_float(cw.y), __uint_as_float(cw.z), __uint_as_float(cw.w)} * (1.0f / 127.0f); }
        if (u.ks >= 0) {
            bf16* o = (bf16*)slab + ((size_t)u.ks * MS + (size_t)(u.pm - 32) * 256) * D;
            FOR_AI_M { const int rl = ai * 128 + wr * 64 + m * 16 + fr; const float sa = rs[u.pm * 256 + rl];
#pragma unroll
                for (int bj = 0; bj < 2; ++bj) { const size_t off = (size_t)rl * D + u.pn * 256 + bj * 128 + wc * 32 + 8 * fq; float p[8];
#pragma unroll
                    for (int n = 0; n < 2; ++n)
#pragma unroll
                        for (int j = 0; j < 4; ++j) p[4 * n + j] = (float)__float_as_int(acc[ai][bj][m][n][j]) * (sa * sw[bj][n][j]);
                    u32x4 w; w.x = cvt_pk_bf16(p[0], p[1]); w.y = cvt_pk_bf16(p[2], p[3]); w.z = cvt_pk_bf16(p[4], p[5]); w.w = cvt_pk_bf16(p[6], p[7]); *(u32x4*)(o + off) = w; } }
            return; }
        float sav[2][4];
#pragma unroll
        for (int ai = 0; ai < 2; ++ai)
#pragma unroll
            for (int m = 0; m < 4; ++m) sav[ai][m] = rs[u.pm * 256 + ai * 128 + wr * 64 + m * 16 + fr];
        FOR_AI_M { const int row = u.pm * 256 + ai * 128 + wr * 64 + m * 16 + fr; const float sa = sav[ai][m];
#pragma unroll
            for (int bj = 0; bj < 2; ++bj) { const size_t off = (size_t)row * D + u.pn * 256 + bj * 128 + wc * 32 + 8 * fq;
                const u32x4 tw = *(const u32x4*)(T + off), xw = *(const u32x4*)(X + off);
                const float t[8] = {bflo(tw.x), bfhi(tw.x), bflo(tw.y), bfhi(tw.y), bflo(tw.z), bfhi(tw.z), bflo(tw.w), bfhi(tw.w)}, x[8] = {bflo(xw.x), bfhi(xw.x), bflo(xw.y), bfhi(xw.y), bflo(xw.z), bfhi(xw.z), bflo(xw.w), bfhi(xw.w)};
                float o[8];
#pragma unroll
                for (int n = 0; n < 2; ++n)
#pragma unroll
                    for (int j = 0; j < 4; ++j) o[4 * n + j] = x[4 * n + j] + sigmoidf_(fmaf((float)__float_as_int(acc[ai][bj][m][n][j]), sa * sw[bj][n][j], bv[bj][n][j])) * t[4 * n + j];
                u32x4 w; w.x = cvt_pk_bf16(o[0], o[1]); w.y = cvt_pk_bf16(o[2], o[3]); w.z = cvt_pk_bf16(o[4], o[5]); w.w = cvt_pk_bf16(o[6], o[7]); *(u32x4*)(X + off) = w; } }
    }
};

struct OrderScores {
    const char* Q; const char* K; int G, c;
    __device__ __forceinline__ bool next(int i, Unit& u) const { const int L = i * G + c; if (L >= 256) return false; u.pm = L; u.pn = 0; u.nt = 4; u.ks = -1; u.a = Q + (size_t)L * 131072; u.b = K + (size_t)L * 131072; return true; }
};
struct OrderUT {
    const char* BC; const char* KT; int G, c;
    __device__ __forceinline__ bool next(int i, Unit& u) const { const int L = i * G + c; if (L >= 512) return false; u.pm = L & 255; u.pn = L >> 8;
        u.nt = 4; u.ks = -1; u.a = BC + ((size_t)u.pm * 512 + u.pn * 256) * 1024; u.b = KT + (size_t)u.pm * 131072; return true; }
};
struct OrderO {
    const char* AC; const char* BC; int G, c, v;
    __device__ __forceinline__ bool next(int i, Unit& u) const {
        int L;
        if (G == 256) {
            if (v < 128) { if (i > 0) return false; L = 128 + v; }
            else { if (i > 2) return false; const int li = v - 128; L = i == 0 ? li : (i == 1 ? li + 256 : 384 + li); } }
        else { L = i * G + c; if (L >= 512) return false; }
        u.pm = L & 255; u.pn = L >> 8;
        u.nt = 8; u.ks = -1; u.a = AC + (size_t)u.pm * 262144; u.b = BC + ((size_t)u.pm * 512 + u.pn * 256) * 1024; return true; }
};
struct OrderLru {
    const char* XC; const char* W; int G, c;
    __device__ __forceinline__ bool next(int i, Unit& u) const { const int L = i * G + c; if (L >= 576) return false; u.pm = L % 36; u.pn = L / 36;
        u.nt = 4; u.ks = -1; u.a = XC + ((size_t)u.pm * 256 * D + (u.pn >> 1) * 256) * 2; u.b = W + (size_t)u.pn * 131072; return true; }
};

#define XB_TMO      128
#define XB_XCNT(j)  (256  + 64 * (j))
#define XB_XSUB(j)  (1280 + 64 * (j))
#define XB_XGEN(j)  (2304 + 64 * (j))
#define XB_TOP      3328
#define XB_TOPGEN   3392
#define XCD_BAR_WORDS 3456
#define XB_SPIN_CAP (1u << 18)
__device__ __forceinline__ unsigned xb_ld(unsigned* p)              { return __hip_atomic_load(p, __ATOMIC_RELAXED, __HIP_MEMORY_SCOPE_AGENT); }
__device__ __forceinline__ unsigned xb_add(unsigned* p, unsigned v) { return __hip_atomic_fetch_add(p, v, __ATOMIC_RELAXED, __HIP_MEMORY_SCOPE_AGENT); }
__device__ __forceinline__ unsigned xb_xcc_id() { return (unsigned)__builtin_amdgcn_s_getreg((3 << 11) | 20) & 0xFu; }
#define XB_SPIN(cond, bar) do { unsigned _sp = 0; while (cond) { __builtin_amdgcn_s_sleep(1); \
    if ((++_sp & 255u) == 0u) { if (xb_ld(&(bar)[XB_TMO])) break; if (_sp > XB_SPIN_CAP) { atomicAdd(&(bar)[XB_TMO], 1u); break; } } } } while (0)
struct XcdBarrier { unsigned* bar; unsigned x; volatile LAS unsigned* st; };
__device__ __forceinline__ XcdBarrier xcd_barrier_post(unsigned* bar, volatile LAS unsigned* st) {
    XcdBarrier b; b.bar = bar; b.x = xb_xcc_id(); b.st = st;
    if (threadIdx.x == 0) (void)xb_add(&bar[XB_XCNT(b.x)], 1u);
    return b;
}
__device__ __forceinline__ void xcd_barrier_complete(unsigned* bar, unsigned x, unsigned& nloc, unsigned& nx) {
    const unsigned G = gridDim.x * gridDim.y * gridDim.z;
    unsigned sum, cnt, mine, sp = 0u;
    for (;;) {
        sum = 0u; cnt = 0u; mine = 0u;
#pragma unroll
        for (unsigned j = 0; j < 16; ++j) { const unsigned c = xb_ld(&bar[XB_XCNT(j)]); sum += c; cnt += (c > 0u) ? 1u : 0u; mine = (j == x) ? c : mine; }
        if (sum == G) break;
        __builtin_amdgcn_s_sleep(1);
        if ((++sp & 255u) == 0u) { if (xb_ld(&bar[XB_TMO])) break; if (sp > XB_SPIN_CAP) { atomicAdd(&bar[XB_TMO], 1u); break; } }
    }
    nloc = mine > 0u ? mine : 1u; nx = cnt > 0u ? cnt : 1u;
}
__device__ __forceinline__ void xcd_barrier(const XcdBarrier& b) {
    asm volatile("s_waitcnt vmcnt(0)" ::: "memory");
    __syncthreads();
    if (threadIdx.x == 0) {
        unsigned* bar = b.bar;
        __builtin_amdgcn_s_waitcnt(0);
        unsigned nloc = b.st[0], nx = b.st[1];
        if (nloc == 0u) { xcd_barrier_complete(bar, b.x, nloc, nx); b.st[0] = nloc; b.st[1] = nx; }
        const unsigned old = xb_add(&bar[XB_XSUB(b.x)], 1u);
        const unsigned gen = old / nloc;
        if (old + 1u == (gen + 1u) * nloc) {
            __builtin_amdgcn_fence(__ATOMIC_RELEASE, "agent");
            asm volatile("s_waitcnt vmcnt(0)" ::: "memory");
            const unsigned og = xb_add(&bar[XB_TOP], 1u);
            const unsigned tg = og / nx;
            if (og + 1u == (tg + 1u) * nx) xb_add(&bar[XB_TOPGEN], 1u);
            else XB_SPIN(xb_ld(&bar[XB_TOPGEN]) == tg, bar);
            __builtin_amdgcn_fence(__ATOMIC_ACQUIRE, "agent");
            xb_add(&bar[XB_XGEN(b.x)], 1u);
            asm volatile("s_waitcnt vmcnt(0)" ::: "memory");
        } else {
            XB_SPIN(xb_ld(&bar[XB_XGEN(b.x)]) == gen, bar);
            __builtin_amdgcn_fence(__ATOMIC_ACQUIRE, "agent");
            asm volatile("s_waitcnt vmcnt(0)" ::: "memory");
        }
    }
    __syncthreads();
}

struct TrItem { const float* W; bf16* WT; size_t drow0; int ldw, k0, n0, ldt; unsigned char* WT8; const unsigned* cm; };
__device__ __forceinline__ void tr_load(const TrItem& t, f32x4 (&v)[8], int lane) {
#pragma unroll
    for (int i = 0; i < 8; ++i) { const int kk = (lane >> 3) + 8 * i, c4 = lane & 7; v[i] = *(const f32x4*)(t.W + (size_t)(t.k0 + kk) * t.ldw + t.n0 + 4 * c4); }
}
__device__ __forceinline__ void tr_finish(const TrItem& t, const f32x4 (&v)[8], LAS float* scr, int lane) {
#pragma unroll
    for (int i = 0; i < 8; ++i) { const int kk = (lane >> 3) + 8 * i, c4 = lane & 7; LAS float* s = scr + kk * 33 + 4 * c4; s[0] = v[i][0]; s[1] = v[i][1]; s[2] = v[i][2]; s[3] = v[i][3]; }
    LDS_WAIT(); asm volatile("" ::: "memory");
    const int c = lane & 7;
#pragma unroll
    for (int j = 0; j < 4; ++j) { const int n = (lane >> 3) + 8 * j; const LAS float* s = scr + (8 * c) * 33 + n;
        if (t.WT8 && t.cm) { const float cmx = __uint_as_float(t.cm[t.drow0 + n]), qs = cmx > 0.f ? 127.0f / cmx : 0.f; u32x2 o8;
            o8.x = f2i8x4(s[0 * 33] * qs, s[1 * 33] * qs, s[2 * 33] * qs, s[3 * 33] * qs); o8.y = f2i8x4(s[4 * 33] * qs, s[5 * 33] * qs, s[6 * 33] * qs, s[7 * 33] * qs);
            *(u32x2*)(t.WT8 + (t.drow0 + n) * (size_t)t.ldt + t.k0 + 8 * c) = o8; }
        else if (t.WT8) { u32x2 o8; o8.x = f2fp8x4(s[0 * 33] * W8_SCALE, s[1 * 33] * W8_SCALE, s[2 * 33] * W8_SCALE, s[3 * 33] * W8_SCALE); o8.y = f2fp8x4(s[4 * 33] * W8_SCALE, s[5 * 33] * W8_SCALE, s[6 * 33] * W8_SCALE, s[7 * 33] * W8_SCALE);
            *(u32x2*)(t.WT8 + (t.drow0 + n) * (size_t)t.ldt + t.k0 + 8 * c) = o8; }
        else { u32x4 o; o.x = cvt_pk_bf16(s[0 * 33], s[1 * 33]); o.y = cvt_pk_bf16(s[2 * 33], s[3 * 33]); o.z = cvt_pk_bf16(s[4 * 33], s[5 * 33]); o.w = cvt_pk_bf16(s[6 * 33], s[7 * 33]);
            *(u32x4*)(t.WT + (t.drow0 + n) * (size_t)t.ldt + t.k0 + 8 * c) = o; } }
    LDS_WAIT(); asm volatile("" ::: "memory");
}
template <bool BF> __device__ __forceinline__ f32x4 ldrow4(const void* row, int i) { if (BF) { const u32x2 w = ((const u32x2*)row)[i]; return (f32x4){bflo(w.x), bfhi(w.x), bflo(w.y), bfhi(w.y)}; } else return ((const f32x4*)row)[i]; }
__device__ __forceinline__ void tr_absmax(const TrItem& t, const f32x4 (&v)[8], unsigned* cm, int lane) {
    f32x4 mx = {0.f, 0.f, 0.f, 0.f};
#pragma unroll
    for (int i = 0; i < 8; ++i)
#pragma unroll
        for (int e = 0; e < 4; ++e) mx[e] = fmaxf(mx[e], fabsf(v[i][e]));
#pragma unroll
    for (int e = 0; e < 4; ++e) { float m = mx[e]; m = fmaxf(m, __shfl_xor(m, 8)); m = fmaxf(m, __shfl_xor(m, 16)); m = fmaxf(m, __shfl_xor(m, 32)); mx[e] = m; }
    if (lane < 8) {
#pragma unroll
        for (int e = 0; e < 4; ++e) atomicMax(cm + t.drow0 + 4 * lane + e, __float_as_uint(mx[e])); }
}
template <bool INBF> __device__ __forceinline__ void rms_row_q8(const void* xrow, const float* gain, unsigned char* qrow, float* rs, int lane, bf16* orow = nullptr) {
    f32x4 v[8]; float s = 0.f;
#pragma unroll
    for (int j = 0; j < 8; ++j) { v[j] = ldrow4<INBF>(xrow, lane + 64 * j); s += (v[j][0] * v[j][0] + v[j][1] * v[j][1]) + (v[j][2] * v[j][2] + v[j][3] * v[j][3]); }
    const float rstd = 1.0f / sqrtf(wave_sum(s) * (1.0f / D) + EPS);
    float mx = 0.f;
#pragma unroll
    for (int j = 0; j < 8; ++j) { const f32x4 g = ((const f32x4*)gain)[lane + 64 * j]; v[j] = v[j] * rstd * g; mx = fmaxf(fmaxf(mx, fmaxf(fabsf(v[j][0]), fabsf(v[j][1]))), fmaxf(fabsf(v[j][2]), fabsf(v[j][3]))); }
    mx = wave_max(mx); const float qs = mx > 0.f ? 127.0f / mx : 0.f;
#pragma unroll
    for (int j = 0; j < 8; ++j) { ((unsigned*)qrow)[lane + 64 * j] = f2i8x4(v[j][0] * qs, v[j][1] * qs, v[j][2] * qs, v[j][3] * qs);
        if (orow) ((u32x2*)orow)[lane + 64 * j] = (u32x2){pk2(v[j][0], v[j][1]), pk2(v[j][2], v[j][3])}; }
    if (lane == 0) *rs = mx * (1.0f / 127.0f);
}
template <bool INBF> __device__ __forceinline__ void rms_row_bf16(const void* xrow, const float* gain, bf16* orow, int lane, unsigned char* o8row = nullptr) {
    f32x4 v[8]; float s = 0.f;
#pragma unroll
    for (int j = 0; j < 8; ++j) { v[j] = ldrow4<INBF>(xrow, lane + 64 * j); s += (v[j][0] * v[j][0] + v[j][1] * v[j][1]) + (v[j][2] * v[j][2] + v[j][3] * v[j][3]); }
    const float rstd = 1.0f / sqrtf(wave_sum(s) * (1.0f / D) + EPS);
    unsigned long long* o8 = (unsigned long long*)orow + lane;
#pragma unroll
    for (int j = 0; j < 8; ++j) { const f32x4 g = ((const f32x4*)gain)[lane + 64 * j];
        o8[64 * j] = (unsigned long long)pk2(v[j][0] * rstd * g[0], v[j][1] * rstd * g[1]) | ((unsigned long long)pk2(v[j][2] * rstd * g[2], v[j][3] * rstd * g[3]) << 32);
        if (o8row) ((unsigned*)o8row)[lane + 64 * j] = f2fp8x4(v[j][0] * rstd * g[0], v[j][1] * rstd * g[1], v[j][2] * rstd * g[2], v[j][3] * rstd * g[3]); }
}
template <bool INBF> __device__ __forceinline__ void rms_row_slab_bf16(const void* base, const float* slabrow, float alpha, bf16* xout, const float* gain, bf16* orow, int lane, unsigned char* o8row = nullptr) {
    f32x4 v[8]; float s = 0.f;
#pragma unroll
    for (int j = 0; j < 8; ++j) { f32x4 a = {0.f, 0.f, 0.f, 0.f};
#pragma unroll
        for (int k = 0; k < 8; ++k) { const u32x2 w = ((const u32x2*)((const bf16*)slabrow + (size_t)k * MS * D))[lane + 64 * j]; a += (f32x4){bflo(w.x), bfhi(w.x), bflo(w.y), bfhi(w.y)}; }
        v[j] = ldrow4<INBF>(base, lane + 64 * j) + alpha * a; ((u32x2*)xout)[lane + 64 * j] = (u32x2){cvt_pk_bf16(v[j][0], v[j][1]), cvt_pk_bf16(v[j][2], v[j][3])};
        s += (v[j][0] * v[j][0] + v[j][1] * v[j][1]) + (v[j][2] * v[j][2] + v[j][3] * v[j][3]); }
    const float rstd = 1.0f / sqrtf(wave_sum(s) * (1.0f / D) + EPS);
    unsigned long long* o8 = (unsigned long long*)orow + lane;
#pragma unroll
    for (int j = 0; j < 8; ++j) { const f32x4 g = ((const f32x4*)gain)[lane + 64 * j];
        o8[64 * j] = (unsigned long long)pk2(v[j][0] * rstd * g[0], v[j][1] * rstd * g[1]) | ((unsigned long long)pk2(v[j][2] * rstd * g[2], v[j][3] * rstd * g[3]) << 32);
        if (o8row) ((unsigned*)o8row)[lane + 64 * j] = f2fp8x4(v[j][0] * rstd * g[0], v[j][1] * rstd * g[1], v[j][2] * rstd * g[2], v[j][3] * rstd * g[3]); }
}
template <bool INBF> __device__ __forceinline__ void rms_row_slab_q8(const void* base, const float* slabrow, float alpha, bf16* xout, const float* gain, unsigned char* qrow, float* rs, int lane, bf16* orow = nullptr) {
    f32x4 v[8]; float s = 0.f;
#pragma unroll
    for (int j = 0; j < 8; ++j) { f32x4 a = {0.f, 0.f, 0.f, 0.f};
#pragma unroll
        for (int k = 0; k < 8; ++k) { const u32x2 w = ((const u32x2*)((const bf16*)slabrow + (size_t)k * MS * D))[lane + 64 * j]; a += (f32x4){bflo(w.x), bfhi(w.x), bflo(w.y), bfhi(w.y)}; }
        v[j] = ldrow4<INBF>(base, lane + 64 * j) + alpha * a; ((u32x2*)xout)[lane + 64 * j] = (u32x2){cvt_pk_bf16(v[j][0], v[j][1]), cvt_pk_bf16(v[j][2], v[j][3])};
        s += (v[j][0] * v[j][0] + v[j][1] * v[j][1]) + (v[j][2] * v[j][2] + v[j][3] * v[j][3]); }
    const float rstd = 1.0f / sqrtf(wave_sum(s) * (1.0f / D) + EPS);
    float mx = 0.f;
#pragma unroll
    for (int j = 0; j < 8; ++j) { const f32x4 g = ((const f32x4*)gain)[lane + 64 * j]; v[j] = v[j] * rstd * g; mx = fmaxf(fmaxf(mx, fmaxf(fabsf(v[j][0]), fabsf(v[j][1]))), fmaxf(fabsf(v[j][2]), fabsf(v[j][3]))); }
    mx = wave_max(mx); const float qs = mx > 0.f ? 127.0f / mx : 0.f;
#pragma unroll
    for (int j = 0; j < 8; ++j) { ((unsigned*)qrow)[lane + 64 * j] = f2i8x4(v[j][0] * qs, v[j][1] * qs, v[j][2] * qs, v[j][3] * qs);
        if (orow) ((u32x2*)orow)[lane + 64 * j] = (u32x2){pk2(v[j][0], v[j][1]), pk2(v[j][2], v[j][3])}; }
    if (lane == 0) *rs = mx * (1.0f / 127.0f);
}
__device__ __forceinline__ void rms_row_f32(const bf16* xrow, const float* gain, float* orow, int lane) {
    f32x4 v[8]; float s = 0.f;
#pragma unroll
    for (int j = 0; j < 8; ++j) { v[j] = ldrow4<true>(xrow, lane + 64 * j); s += (v[j][0] * v[j][0] + v[j][1] * v[j][1]) + (v[j][2] * v[j][2] + v[j][3] * v[j][3]); }
    const float rstd = 1.0f / sqrtf(wave_sum(s) * (1.0f / D) + EPS);
#pragma unroll
    for (int j = 0; j < 8; ++j) { const f32x4 g = ((const f32x4*)gain)[lane + 64 * j]; ((f32x4*)orow)[lane + 64 * j] = v[j] * rstd * g; }
}

__device__ __forceinline__ void rms_row_ple_f32(const bf16* xrow, const float* slabrow, const float* bg, const bf16* trow, const float* gain, float* orow, int lane) {
    f32x4 v[8]; float s = 0.f;
#pragma unroll
    for (int j = 0; j < 8; ++j) { f32x4 a = ((const f32x4*)bg)[lane + 64 * j];
#pragma unroll
        for (int k = 0; k < 8; ++k) { const u32x2 w = ((const u32x2*)((const bf16*)slabrow + (size_t)k * MS * D))[lane + 64 * j]; a += (f32x4){bflo(w.x), bfhi(w.x), bflo(w.y), bfhi(w.y)}; }
        const u32x2 tw = ((const u32x2*)trow)[lane + 64 * j]; const f32x4 t = {bflo(tw.x), bfhi(tw.x), bflo(tw.y), bfhi(tw.y)}, x = ldrow4<true>(xrow, lane + 64 * j);
#pragma unroll
        for (int e = 0; e < 4; ++e) v[j][e] = x[e] + sigmoidf_(a[e]) * t[e];
        s += (v[j][0] * v[j][0] + v[j][1] * v[j][1]) + (v[j][2] * v[j][2] + v[j][3] * v[j][3]); }
    const float rstd = 1.0f / sqrtf(wave_sum(s) * (1.0f / D) + EPS);
#pragma unroll
    for (int j = 0; j < 8; ++j) { const f32x4 g = ((const f32x4*)gain)[lane + 64 * j]; ((f32x4*)orow)[lane + 64 * j] = v[j] * rstd * g; }
}

struct Args { const float* in[34]; float* out; unsigned char* ws; int ph_lo, ph_hi; };
constexpr int NPHASE = 17;

__global__ void __launch_bounds__(NWAVES * 64, 2) mega_fwd(Args args) {
    extern __shared__ __attribute__((aligned(16))) unsigned char lds_raw[];
    LAS unsigned char* lds = (LAS unsigned char*)lds_raw;
    volatile LAS unsigned* MISC = (volatile LAS unsigned*)(lds + MISC_OFF);
    const int tid = threadIdx.x, lane = tid & 63, wave = __builtin_amdgcn_readfirstlane(tid >> 6);
    const int G = gridDim.x, bx = blockIdx.x;
    const int vcu = (G % 8 == 0) ? (bx % 8) * (G / 8) + bx / 8 : bx;
    const int gw = vcu * NWAVES + wave, NGW = G * NWAVES;
    const bool rb_ = (G == 256), ra_ = wave < 4; const int ria_ = vcu * 4 + (wave & 3);
    const int rnk_ = rb_ ? (ra_ ? 3 : 6) : (M + NGW - 1 - gw) / NGW;
#define ROWMAP(k) (rb_ ? (ra_ ? ((k) == 0 ? MP + ria_ : 2 * ria_ + (k) - 1) : 2048 + ria_ * 6 + (k)) : gw + (k) * NGW)
    const int gt = vcu * (NWAVES * 64) + tid, NGT = G * NWAVES * 64;
    unsigned char* ws = args.ws;
    gu32* ctl = (gu32*)(ws + WS_CTL);
    for (int w = tid; w < (LDS_BYTES - LDSCTL_OFF) / 4; w += NWAVES * 64) ((LAS unsigned*)(lds + LDSCTL_OFF))[w] = 0u;
    __syncthreads();
    XcdBarrier bar = xcd_barrier_post((unsigned*)(ctl + CW_BAR), MISC + 8);
    const int lo = args.ph_lo, hi = args.ph_hi;
#define IN(k) (lo <= (k) && (k) < hi)
#define SEAM(k) do { if (IN(k) && IN((k) + 1)) xcd_barrier(bar); } while (0)

#define x_prompt (args.in[0])
#define x_sample (args.in[1])
#define p_prompt (args.in[2])
#define p_sample (args.in[3])
#define state_lru (args.in[4])
#define state_conv (args.in[5])
#define state_ret (args.in[6])
#define ffn1_norm (args.in[7])
#define mix_norm (args.in[11])
#define b_in (args.in[13])
#define conv_w (args.in[14])
#define conv_b (args.in[15])
#define lru_ba (args.in[17])
#define lru_bx (args.in[19])
#define lru_lambda (args.in[20])
#define ret_norm (args.in[21])
#define ffn2_norm (args.in[25])
#define ple_norm (args.in[29])
#define ple_bg (args.in[31])
#define final_norm (args.in[33])
#define out (args.out)
#define W1A ((bf16*)(ws + WS_W1A))
#define W1D ((bf16*)(ws + WS_W1D))
#define W2A ((bf16*)(ws + WS_W2A))
#define W2D ((bf16*)(ws + WS_W2D))
#define WIN ((bf16*)(ws + WS_WIN))
#define WPA ((bf16*)(ws + WS_WPA))
#define WPB ((bf16*)(ws + WS_WPB))
#define WOUT ((bf16*)(ws + WS_WOUT))
#define WPG ((bf16*)(ws + WS_WPG))
#define WPP ((bf16*)(ws + WS_WPP))
#define WLRU ((bf16*)(ws + WS_WLRU))
#define COS ((float*)(ws + WS_COS))
#define SIN ((float*)(ws + WS_SIN))
#define U ((bf16*)(ws + WS_U))
#define HB ((bf16*)(ws + WS_HB))
#define X ((bf16*)(ws + WS_X))
#define XA ((bf16*)(ws + WS_XA))
#define SLAB ((float*)(ws + WS_XA))
#define GA ((bf16*)(ws + WS_GA))
#define Qb ((bf16*)(ws + WS_Q))
#define Kb ((bf16*)(ws + WS_K))
#define ACAT ((bf16*)(ws + WS_ACAT))
#define BCAT ((bf16*)(ws + WS_BCAT))
#define KTD ((bf16*)(ws + WS_KTD))
#define VTS ((bf16*)(ws + WS_VTS))
#define SG ((bf16*)(ws + WS_SG))
#define SA ((bf16*)(ws + WS_SA))
#define SB ((bf16*)(ws + WS_SB))
#define XC ((bf16*)(ws + WS_XC))
#define AA ((bf16*)(ws + WS_AA))
#define BB ((bf16*)(ws + WS_BB))
#define HL ((bf16*)(ws + WS_HL))
#define PC ((bf16*)(ws + WS_PC))
#define AGA ((float*)(ws + WS_AGA))
#define AGB ((float*)(ws + WS_AGB))
#define OA ((bf16*)(ws + WS_OA))
#define UT ((float*)(ws + WS_UT))
#define OF ((bf16*)(ws + WS_OF))
#define OB ((bf16*)(ws + WS_OB))
#define TMP ((float*)(ws + WS_TMP))
#define TMP2 ((float*)(ws + WS_TMP2))
#define MG ((bf16*)(ws + WS_MG))
#define PEB ((bf16*)(ws + WS_PE))
#define U8 ((unsigned char*)(ws + WS_U8))
#define WIN8 ((unsigned char*)(ws + WS_WIN8))
#define RS ((float*)(ws + WS_RS))
    LAS float* scr = (LAS float*)(lds + wave * 16384);
    constexpr int I_FA = 32 * 176, I_FD = 88 * 64, I_IN = 32 * 640, I_PA = 32 * 64, I_PB = 64 * 64, I_PP = 4 * 64, I_L = 4 * 8;
    constexpr int NITEMS = 6 * I_FA + I_IN + 3 * I_PA + I_PB + I_PP + 16 * I_L;
    static_assert(I_FA == I_FD, "ffn item counts");
    auto item = [&](int it) -> TrItem { TrItem t; t.WT8 = nullptr; t.cm = nullptr; int r = it;
        if (r < 6 * I_FA) { const int w = r / I_FA; r -= w * I_FA; const int f = w / 3, k = w % 3; t.W = args.in[(f ? 26 : 8) + k];
            if (k < 2) { const int kb = r / 176, nb = r % 176, n0 = nb * 32; t.ldw = FF; t.k0 = kb * 64; t.n0 = n0; t.WT = f ? W2A : W1A; t.drow0 = (size_t)(n0 >> 7) * 256 + k * 128 + (n0 & 127); t.ldt = D; t.WT8 = (unsigned char*)(f ? W2A : W1A); t.cm = (const unsigned*)(ctl + (f ? CW_CM2 : CW_CM1)); }
            else { const int kb = r / 64, nb = r % 64; t.ldw = D; t.k0 = kb * 64; t.n0 = nb * 32; t.WT = f ? W2D : W1D; t.drow0 = (size_t)nb * 32; t.ldt = FF; t.WT8 = (unsigned char*)(f ? W2D : W1D); }
            return t; }
        r -= 6 * I_FA;
        if (r < I_IN) { const int kb = r / 640, nb = r % 640; t.W = args.in[12]; t.ldw = NIN; t.k0 = kb * 64; t.n0 = nb * 32; t.WT = WIN; t.drow0 = (size_t)nb * 32; t.ldt = D; { const int ct = nb >> 3; if ((ct >= 8 && ct < 24) || ct >= 48) { t.WT8 = WIN8; t.cm = (const unsigned*)(ctl + CW_CM3); } } return t; } r -= I_IN;
        if (r < I_PA) { const int kb = r / 64, nb = r % 64; t.W = args.in[22]; t.ldw = D; t.k0 = kb * 64; t.n0 = nb * 32; t.WT = WPA; t.drow0 = (size_t)nb * 32; t.ldt = D; return t; } r -= I_PA;
        if (r < I_PB) { const int kb = r / 64, nb = r % 64; t.W = args.in[23]; t.ldw = D; t.k0 = kb * 64; t.n0 = nb * 32; t.WT = WPB; t.drow0 = (size_t)nb * 32; t.ldt = VD; t.WT8 = (unsigned char*)WPB; return t; } r -= I_PB;
        if (r < I_PA) { const int kb = r / 64, nb = r % 64; t.W = args.in[24]; t.ldw = D; t.k0 = kb * 64; t.n0 = nb * 32; t.WT = WOUT; t.drow0 = (size_t)nb * 32; t.ldt = D; return t; } r -= I_PA;
        if (r < I_PA) { const int kb = r / 64, nb = r % 64; t.W = args.in[30]; t.ldw = D; t.k0 = kb * 64; t.n0 = nb * 32; t.WT = WPG; t.drow0 = (size_t)nb * 32; t.ldt = D; t.WT8 = (unsigned char*)WPG; t.cm = (const unsigned*)(ctl + CW_CM4); return t; } r -= I_PA;
        if (r < I_PP) { const int kb = r / 64, nb = r % 64; t.W = args.in[32]; t.ldw = D; t.k0 = kb * 64; t.n0 = nb * 32; t.WT = WPP; t.drow0 = (size_t)nb * 32; t.ldt = PLE; return t; } r -= I_PP;
        { const int mat = r / I_L, q = r % I_L, which = mat >> 3, blk = mat & 7, kb = q / 8, nb = q % 8, n0 = nb * 32;
          t.W = args.in[which ? 18 : 16] + (size_t)blk * 65536; t.ldw = 256; t.k0 = kb * 64; t.n0 = n0; t.WT = WLRU; t.drow0 = (size_t)(2 * blk + (n0 >> 7)) * 256 + which * 128 + (n0 & 127); t.ldt = 256; return t; } };
    constexpr int R_W1A0 = 0, R_W1D0 = 2 * I_FA, R_W2A0 = 3 * I_FA, R_W2D0 = 5 * I_FA, R_WIN0 = 6 * I_FA, R_PA0 = R_WIN0 + I_IN, R_PB0 = R_PA0 + I_PA, R_WOUT0 = R_PB0 + I_PB, R_WPG0 = R_WOUT0 + I_PA, R_WPP0 = R_WPG0 + I_PA, R_LRU0 = R_WPP0 + I_PP;
    static_assert(R_LRU0 + 16 * I_L == NITEMS, "item ranges");
    auto convert = [&](int lo, int hi, int wk, int nwk) {
        f32x4 va[8], vb[8]; int it = lo + wk; TrItem ta, tb;
        if (it < hi) { ta = item(it); tr_load(ta, va, lane); }
        while (it < hi) {
            const int itb = it + nwk, itc = it + 2 * nwk;
            if (itb < hi) { tb = item(itb); tr_load(tb, vb, lane); }
            tr_finish(ta, va, scr, lane);
            if (itc < hi) { ta = item(itc); tr_load(ta, va, lane); }
            if (itb < hi) tr_finish(tb, vb, scr, lane);
            it = itc; } };
    auto absmax = [&](int lo, int hi, int wk, int nwk, unsigned* cm) {
        f32x4 va[8], vb[8]; int it = lo + wk; TrItem ta, tb;
        bool ha = false, hb = false;
        if (it < hi) { ta = item(it); ha = ta.cm != nullptr; if (ha) tr_load(ta, va, lane); }
        while (it < hi) {
            const int itb = it + nwk, itc = it + 2 * nwk;
            hb = false; if (itb < hi) { tb = item(itb); hb = tb.cm != nullptr; if (hb) tr_load(tb, vb, lane); }
            if (ha) tr_absmax(ta, va, cm, lane);
            ha = false; if (itc < hi) { ta = item(itc); ha = ta.cm != nullptr; if (ha) tr_load(ta, va, lane); }
            if (hb) tr_absmax(tb, vb, cm, lane);
            it = itc; } };
    if (IN(0)) {
        absmax(R_W1A0, R_W1D0, gw, NGW, (unsigned*)(ctl + CW_CM1));
        convert(R_W1D0, R_W1D0 + I_FA, gw, NGW);
        absmax(R_WIN0, R_WIN0 + I_IN, gw, NGW, (unsigned*)(ctl + CW_CM3));
        for (int i = gt; i < 2056 * 128; i += NGT) { const int tp = i >> 7, f = i & 127; const int pos = tp < 2048 ? tp : 16384 + (tp - 2048);
            const float inv = exp2f(-(float)f * (13.287712379549449f / 128.0f)); const float ang = (float)pos * inv; COS[i] = cosf(ang); SIN[i] = sinf(ang); }
        for (int i = gt; i < M * PLE / 4; i += NGT) { const int row = i >> 6, c4 = i & 63;
            const f32x4 v = (row < MP) ? ((const f32x4*)p_prompt)[(size_t)row * 64 + c4] : ((const f32x4*)p_sample)[(size_t)(row - MP) * 64 + c4];
            ((u32x2*)PEB)[i] = (u32x2){pk2(v[0], v[1]), pk2(v[2], v[3])}; }
        for (int m = gw; m < M; m += NGW) rms_row_q8<false>(m < MP ? x_prompt + (size_t)m * D : x_sample + (size_t)(m - MP) * D, ffn1_norm, U8 + (size_t)m * D, RS + m, lane);
        __syncthreads();
        xcd_barrier(bar);
        convert(R_W1A0, R_W1D0, gw, NGW);
        __syncthreads();
    }
    SEAM(0);
    if (IN(1)) { pg8::TileOrder S; S.init(U8, (size_t)256 * D, W1A, (size_t)256 * D, 36, 44, D / 128, G, bx); EpiSwigluQ8 E{(unsigned char*)HB, RS, (const unsigned*)(ctl + CW_CM1)};
        pg8::gemm_phase<EpiSwigluQ8, pg8::TileOrder, 2>(lds, D / 2, D / 2, S, E);
        if (bx >= 1584 - 6 * 256) convert(R_WIN0, R_WIN0 + I_IN, (bx - (1584 - 6 * 256)) * NWAVES + wave, (G - (1584 - 6 * 256)) * NWAVES); }
    SEAM(1);
    if (IN(2)) { pg8::SplitOrder S; S.init(HB, (size_t)256 * FF, W1D, (size_t)256 * FF, FF / 128, G, bx); EpiResid<false> E{x_prompt, X, 0.5f / (H8_SCALE * W8_SCALE), SLAB, 1.0f / (H8_SCALE * W8_SCALE)};
        pg8::gemm_phase<EpiResid<false>, pg8::SplitOrder, 1>(lds, FF / 2, FF / 2, S, E); }
    SEAM(2);
    if (IN(3)) { for (int k_ = 0; k_ < rnk_; ++k_) { const int m = ROWMAP(k_); if (m < MP) rms_row_q8<true>(X + (size_t)m * D, mix_norm, U8 + (size_t)m * D, RS + m, lane, U + (size_t)m * D);
            else rms_row_slab_q8<false>(x_sample + (size_t)(m - MP) * D, (const float*)((const bf16*)SLAB + (size_t)(m - MP) * D), 0.5f, X + (size_t)m * D, mix_norm, U8 + (size_t)m * D, RS + m, lane, U + (size_t)m * D); } }
    SEAM(3);
    if (IN(4)) {
        { pg8::TileOrder S; S.init(U8, (size_t)256 * D, WIN8, (size_t)256 * D, 36, 48, D / 128, G, bx); S.pn_s1 = 16; S.pn_a = 8; S.pn_b = 48;
          EpiMix<true> E{b_in, COS, SIN, XA, GA, Qb, Kb, ACAT, BCAT, KTD, VTS, SG, SA, SB, lds + XPOSE_OFF, RS, (const unsigned*)(ctl + CW_CM3)};
          pg8::gemm_phase<EpiMix<true>, pg8::TileOrder, 2>(lds, D / 2, D / 2, S, E); }
        { pg8::TileOrder S; S.init(U, (size_t)256 * D * 2, WIN, (size_t)256 * D * 2, 36, 32, D / 64, G, (bx + G - 1728 % G) % G); S.pn_s1 = 8; S.pn_s2 = 16; S.pn_a = 0; S.pn_b = 24; S.pn_c = 32;
          EpiMix<false> E{b_in, COS, SIN, XA, GA, Qb, Kb, ACAT, BCAT, KTD, VTS, SG, SA, SB, lds + XPOSE_OFF, RS, (const unsigned*)(ctl + CW_CM3)};
          pg8::gemm_phase<EpiMix<false>, pg8::TileOrder, 0>(lds, D, D, S, E); }
        { const int c2 = (bx + G - 1728 % G) % G, nlast = G / 2;
          if (c2 >= nlast) { const int wk = (c2 - nlast) * NWAVES + wave, nwk = (G - nlast) * NWAVES;
            convert(R_LRU0, NITEMS, wk, nwk); convert(R_PA0, R_WPG0, wk, nwk); absmax(R_W2A0, R_W2D0, wk, nwk, (unsigned*)(ctl + CW_CM2)); absmax(R_WPG0, R_WPP0, wk, nwk, (unsigned*)(ctl + CW_CM4)); } }
    }
    SEAM(4);
    if (IN(5)) {
        if (bx & 1) {
        {
            LAS float* tab = (LAS float*)lds;
            LAS float* red = (LAS float*)(lds + 16384);
            LAS float* scs = (LAS float*)(lds + 16384 + 65536);
            for (int un = vcu; un < NBS * NH; un += G) {
                const int b = un >> 3, hh = un & 7; const float l2g = log2gamma(hh);
                const bf16* q = Qb + (size_t)32 * 2048 * 256 + (size_t)un * 2048; const bf16* k = Kb + (size_t)32 * 2048 * 256 + (size_t)un * 2048; const bf16* vt = VTS + (size_t)un * 4096;
                const float* S0 = state_ret + (size_t)un * 131072; float* Sn = out + O_RETS + (size_t)un * 131072;
                { const int dk = tid >> 1, which = tid & 1; const bf16* src = which ? k : q;
#pragma unroll
                  for (int i = 0; i < 8; ++i) tab[dk * 16 + which * 8 + i] = bf1(src[i * 256 + dk]) * fast_exp2((float)(which ? 7 - i : i + 1) * l2g); }
                { const int i = wave;
                  const u32x2 qw = ((const u32x2*)(q + i * 256))[lane]; const float q0 = bflo(qw.x), q1 = bfhi(qw.x), q2 = bflo(qw.y), q3 = bfhi(qw.y);
                  for (int j = 0; j < 8; ++j) { const u32x2 kw = ((const u32x2*)(k + j * 256))[lane];
                      float d = q0 * bflo(kw.x) + q1 * bfhi(kw.x) + q2 * bflo(kw.y) + q3 * bfhi(kw.y); d = wave_sum(d);
                      if (lane == 0) scs[i * 8 + j] = (j <= i) ? d * fast_exp2((float)(i - j) * l2g) : 0.0f; } }
                __syncthreads();
                const int dkq = tid >> 7, dv4 = tid & 127;
                float vv[4][8];
#pragma unroll
                for (int e = 0; e < 4; ++e) { const u32x4 w = *(const u32x4*)(vt + (size_t)(4 * dv4 + e) * 8);
                    vv[e][0] = bflo(w.x); vv[e][1] = bfhi(w.x); vv[e][2] = bflo(w.y); vv[e][3] = bfhi(w.y); vv[e][4] = bflo(w.z); vv[e][5] = bfhi(w.z); vv[e][6] = bflo(w.w); vv[e][7] = bfhi(w.w); }
                f32x4 cross[8];
#pragma unroll
                for (int i = 0; i < 8; ++i) cross[i] = (f32x4){0.f, 0.f, 0.f, 0.f};
                const float g8 = fast_exp2(8.0f * l2g);
                for (int it0 = 0; it0 < 64; it0 += 16) {
                    f32x4 sv[16];
#pragma unroll
                    for (int q2 = 0; q2 < 16; ++q2) sv[q2] = __builtin_nontemporal_load((const f32x4*)(S0 + (size_t)(4 * (it0 + q2) + dkq) * 512) + dv4);
#pragma unroll
                    for (int q2 = 0; q2 < 16; ++q2) { const int dk = 4 * (it0 + q2) + dkq; const f32x4 s = sv[q2];
                        const LAS f32x4* tq = (const LAS f32x4*)(tab + dk * 16); const f32x4 qa = tq[0], qb = tq[1], ka = tq[2], kb = tq[3];
                        cross[0] += qa[0] * s; cross[1] += qa[1] * s; cross[2] += qa[2] * s; cross[3] += qa[3] * s; cross[4] += qb[0] * s; cross[5] += qb[1] * s; cross[6] += qb[2] * s; cross[7] += qb[3] * s;
                        f32x4 sn = g8 * s;
#pragma unroll
                        for (int e = 0; e < 4; ++e) sn[e] += ka[0] * vv[e][0] + ka[1] * vv[e][1] + ka[2] * vv[e][2] + ka[3] * vv[e][3] + kb[0] * vv[e][4] + kb[1] * vv[e][5] + kb[2] * vv[e][6] + kb[3] * vv[e][7];
                        __builtin_nontemporal_store(sn, (f32x4*)(Sn + (size_t)dk * 512) + dv4); } }
#pragma unroll
                for (int i = 0; i < 8; ++i) *(LAS f32x4*)(red + ((dkq * 8 + i) * 512 + 4 * dv4)) = cross[i];
                __syncthreads();
                { const int dv = tid; const u32x4 w = *(const u32x4*)(vt + (size_t)dv * 8);
                  const float v[8] = {bflo(w.x), bfhi(w.x), bflo(w.y), bfhi(w.y), bflo(w.z), bfhi(w.z), bflo(w.w), bfhi(w.w)};
                  float o[8];
#pragma unroll
                  for (int i = 0; i < 8; ++i) { float a = (red[(0 * 8 + i) * 512 + dv] + red[(1 * 8 + i) * 512 + dv]) + (red[(2 * 8 + i) * 512 + dv] + red[(3 * 8 + i) * 512 + dv]);
#pragma unroll
                      for (int j = 0; j < 8; ++j) a += scs[i * 8 + j] * v[j];
                      o[i] = a; const float ss = wave_sum(a * a); if (lane == 0) scs[64 + wave * 8 + i] = ss; }
                  __syncthreads();
                  const float gn = ret_norm[hh * 512 + dv];
#pragma unroll
                  for (int i = 0; i < 8; ++i) { float tot = 0.f;
#pragma unroll
                      for (int w8 = 0; w8 < 8; ++w8) tot += scs[64 + w8 * 8 + i];
                      const float rstd = 1.0f / sqrtf(tot * (1.0f / 512.0f) + EPS); const size_t off = (size_t)(MP + b * 8 + i) * VD + hh * 512 + dv;
                      ((unsigned char*)OB)[off] = (unsigned char)(f2fp8x4(__builtin_amdgcn_fmed3f(o[i] * rstd * gn * bf1(SG[off]) * O8_SCALE, -440.0f, 440.0f), 0.f, 0.f, 0.f) & 255u); } }
                __syncthreads();
            }
        }
        for (int it = gt; it < (M / 8) * 512; it += NGT) { const int rc = it >> 9, c4 = it & 511, r0 = rc * 8;
            const f32x4 w0 = ((const f32x4*)conv_w)[c4], w1 = ((const f32x4*)conv_w)[512 + c4], w2 = ((const f32x4*)conv_w)[1024 + c4], w3 = ((const f32x4*)conv_w)[1536 + c4], cb = ((const f32x4*)conv_b)[c4];
            const u32x2* xa4 = (const u32x2*)XA + c4; f32x4 p0, p1, p2; const f32x4 z = {0.f, 0.f, 0.f, 0.f};
#define XA_ROW(r) ({ const u32x2 w_ = xa4[(size_t)(r) * 512]; (f32x4){bflo(w_.x), bfhi(w_.x), bflo(w_.y), bfhi(w_.y)}; })
            if (r0 < MP) { if ((r0 & (TP - 1)) == 0) { p0 = z; p1 = z; p2 = z; } else { p0 = XA_ROW(r0 - 3); p1 = XA_ROW(r0 - 2); p2 = XA_ROW(r0 - 1); } }
            else { const int b = (r0 - MP) >> 3; const f32x4* sc = (const f32x4*)state_conv + (size_t)b * 3 * 512 + c4; p0 = sc[0]; p1 = sc[512]; p2 = sc[1024]; }
            f32x4 cur[8];
#pragma unroll
            for (int t = 0; t < 8; ++t) cur[t] = XA_ROW(r0 + t);
#undef XA_ROW
#pragma unroll
            for (int t = 0; t < 8; ++t) { const f32x4 y = cb + w0 * p0 + w1 * p1 + w2 * p2 + w3 * cur[t];
                ((u32x2*)XC)[(size_t)(r0 + t) * 512 + c4] = (u32x2){pk2(y[0], y[1]), pk2(y[2], y[3])}; p0 = p1; p1 = p2; p2 = cur[t]; }
            if (r0 < MP) { if (((r0 + 8) & (TP - 1)) == 0) { const int b = r0 >> 11; f32x4* o = (f32x4*)(out + O_CONVP) + (size_t)b * 3 * 512 + c4; o[0] = cur[5]; o[512] = cur[6]; o[1024] = cur[7]; } }
            else { const int b = (r0 - MP) >> 3; f32x4* o = (f32x4*)(out + O_CONVS) + (size_t)b * 3 * 512 + c4; o[0] = cur[5]; o[512] = cur[6]; o[1024] = cur[7]; }
        }
        { OrderScores S{(const char*)Qb, (const char*)Kb, G, bx}; EpiScores E{ACAT}; pg8::gemm_phase(lds, 256, 256, S, E); }
        { OrderUT S{(const char*)BCAT, (const char*)KTD, G, bx}; EpiUT E{(bf16*)UT}; pg8::gemm_phase(lds, 512, 256, S, E); }
        } else {
        for (int it = gt; it < (M / 8) * 512; it += NGT) { const int rc = it >> 9, c4 = it & 511, r0 = rc * 8;
            const f32x4 w0 = ((const f32x4*)conv_w)[c4], w1 = ((const f32x4*)conv_w)[512 + c4], w2 = ((const f32x4*)conv_w)[1024 + c4], w3 = ((const f32x4*)conv_w)[1536 + c4], cb = ((const f32x4*)conv_b)[c4];
            const u32x2* xa4 = (const u32x2*)XA + c4; f32x4 p0, p1, p2; const f32x4 z = {0.f, 0.f, 0.f, 0.f};
#define XA_ROW(r) ({ const u32x2 w_ = xa4[(size_t)(r) * 512]; (f32x4){bflo(w_.x), bfhi(w_.x), bflo(w_.y), bfhi(w_.y)}; })
            if (r0 < MP) { if ((r0 & (TP - 1)) == 0) { p0 = z; p1 = z; p2 = z; } else { p0 = XA_ROW(r0 - 3); p1 = XA_ROW(r0 - 2); p2 = XA_ROW(r0 - 1); } }
            else { const int b = (r0 - MP) >> 3; const f32x4* sc = (const f32x4*)state_conv + (size_t)b * 3 * 512 + c4; p0 = sc[0]; p1 = sc[512]; p2 = sc[1024]; }
            f32x4 cur[8];
#pragma unroll
            for (int t = 0; t < 8; ++t) cur[t] = XA_ROW(r0 + t);
#undef XA_ROW
#pragma unroll
            for (int t = 0; t < 8; ++t) { const f32x4 y = cb + w0 * p0 + w1 * p1 + w2 * p2 + w3 * cur[t];
                ((u32x2*)XC)[(size_t)(r0 + t) * 512 + c4] = (u32x2){pk2(y[0], y[1]), pk2(y[2], y[3])}; p0 = p1; p1 = p2; p2 = cur[t]; }
            if (r0 < MP) { if (((r0 + 8) & (TP - 1)) == 0) { const int b = r0 >> 11; f32x4* o = (f32x4*)(out + O_CONVP) + (size_t)b * 3 * 512 + c4; o[0] = cur[5]; o[512] = cur[6]; o[1024] = cur[7]; } }
            else { const int b = (r0 - MP) >> 3; f32x4* o = (f32x4*)(out + O_CONVS) + (size_t)b * 3 * 512 + c4; o[0] = cur[5]; o[512] = cur[6]; o[1024] = cur[7]; }
        }
        { OrderScores S{(const char*)Qb, (const char*)Kb, G, bx}; EpiScores E{ACAT}; pg8::gemm_phase(lds, 256, 256, S, E); }
        { OrderUT S{(const char*)BCAT, (const char*)KTD, G, bx}; EpiUT E{(bf16*)UT}; pg8::gemm_phase(lds, 512, 256, S, E); }
        {
            LAS float* tab = (LAS float*)lds;
            LAS float* red = (LAS float*)(lds + 16384);
            LAS float* scs = (LAS float*)(lds + 16384 + 65536);
            for (int un = vcu; un < NBS * NH; un += G) {
                const int b = un >> 3, hh = un & 7; const float l2g = log2gamma(hh);
                const bf16* q = Qb + (size_t)32 * 2048 * 256 + (size_t)un * 2048; const bf16* k = Kb + (size_t)32 * 2048 * 256 + (size_t)un * 2048; const bf16* vt = VTS + (size_t)un * 4096;
                const float* S0 = state_ret + (size_t)un * 131072; float* Sn = out + O_RETS + (size_t)un * 131072;
                { const int dk = tid >> 1, which = tid & 1; const bf16* src = which ? k : q;
#pragma unroll
                  for (int i = 0; i < 8; ++i) tab[dk * 16 + which * 8 + i] = bf1(src[i * 256 + dk]) * fast_exp2((float)(which ? 7 - i : i + 1) * l2g); }
                { const int i = wave;
                  const u32x2 qw = ((const u32x2*)(q + i * 256))[lane]; const float q0 = bflo(qw.x), q1 = bfhi(qw.x), q2 = bflo(qw.y), q3 = bfhi(qw.y);
                  for (int j = 0; j < 8; ++j) { const u32x2 kw = ((const u32x2*)(k + j * 256))[lane];
                      float d = q0 * bflo(kw.x) + q1 * bfhi(kw.x) + q2 * bflo(kw.y) + q3 * bfhi(kw.y); d = wave_sum(d);
                      if (lane == 0) scs[i * 8 + j] = (j <= i) ? d * fast_exp2((float)(i - j) * l2g) : 0.0f; } }
                __syncthreads();
                const int dkq = tid >> 7, dv4 = tid & 127;
                float vv[4][8];
#pragma unroll
                for (int e = 0; e < 4; ++e) { const u32x4 w = *(const u32x4*)(vt + (size_t)(4 * dv4 + e) * 8);
                    vv[e][0] = bflo(w.x); vv[e][1] = bfhi(w.x); vv[e][2] = bflo(w.y); vv[e][3] = bfhi(w.y); vv[e][4] = bflo(w.z); vv[e][5] = bfhi(w.z); vv[e][6] = bflo(w.w); vv[e][7] = bfhi(w.w); }
                f32x4 cross[8];
#pragma unroll
                for (int i = 0; i < 8; ++i) cross[i] = (f32x4){0.f, 0.f, 0.f, 0.f};
                const float g8 = fast_exp2(8.0f * l2g);
                for (int it0 = 0; it0 < 64; it0 += 16) {
                    f32x4 sv[16];
#pragma unroll
                    for (int q2 = 0; q2 < 16; ++q2) sv[q2] = __builtin_nontemporal_load((const f32x4*)(S0 + (size_t)(4 * (it0 + q2) + dkq) * 512) + dv4);
#pragma unroll
                    for (int q2 = 0; q2 < 16; ++q2) { const int dk = 4 * (it0 + q2) + dkq; const f32x4 s = sv[q2];
                        const LAS f32x4* tq = (const LAS f32x4*)(tab + dk * 16); const f32x4 qa = tq[0], qb = tq[1], ka = tq[2], kb = tq[3];
                        cross[0] += qa[0] * s; cross[1] += qa[1] * s; cross[2] += qa[2] * s; cross[3] += qa[3] * s; cross[4] += qb[0] * s; cross[5] += qb[1] * s; cross[6] += qb[2] * s; cross[7] += qb[3] * s;
                        f32x4 sn = g8 * s;
#pragma unroll
                        for (int e = 0; e < 4; ++e) sn[e] += ka[0] * vv[e][0] + ka[1] * vv[e][1] + ka[2] * vv[e][2] + ka[3] * vv[e][3] + kb[0] * vv[e][4] + kb[1] * vv[e][5] + kb[2] * vv[e][6] + kb[3] * vv[e][7];
                        __builtin_nontemporal_store(sn, (f32x4*)(Sn + (size_t)dk * 512) + dv4); } }
#pragma unroll
                for (int i = 0; i < 8; ++i) *(LAS f32x4*)(red + ((dkq * 8 + i) * 512 + 4 * dv4)) = cross[i];
                __syncthreads();
                { const int dv = tid; const u32x4 w = *(const u32x4*)(vt + (size_t)dv * 8);
                  const float v[8] = {bflo(w.x), bfhi(w.x), bflo(w.y), bfhi(w.y), bflo(w.z), bfhi(w.z), bflo(w.w), bfhi(w.w)};
                  float o[8];
#pragma unroll
                  for (int i = 0; i < 8; ++i) { float a = (red[(0 * 8 + i) * 512 + dv] + red[(1 * 8 + i) * 512 + dv]) + (red[(2 * 8 + i) * 512 + dv] + red[(3 * 8 + i) * 512 + dv]);
#pragma unroll
                      for (int j = 0; j < 8; ++j) a += scs[i * 8 + j] * v[j];
                      o[i] = a; const float ss = wave_sum(a * a); if (lane == 0) scs[64 + wave * 8 + i] = ss; }
                  __syncthreads();
                  const float gn = ret_norm[hh * 512 + dv];
#pragma unroll
                  for (int i = 0; i < 8; ++i) { float tot = 0.f;
#pragma unroll
                      for (int w8 = 0; w8 < 8; ++w8) tot += scs[64 + w8 * 8 + i];
                      const float rstd = 1.0f / sqrtf(tot * (1.0f / 512.0f) + EPS); const size_t off = (size_t)(MP + b * 8 + i) * VD + hh * 512 + dv;
                      ((unsigned char*)OB)[off] = (unsigned char)(f2fp8x4(__builtin_amdgcn_fmed3f(o[i] * rstd * gn * bf1(SG[off]) * O8_SCALE, -440.0f, 440.0f), 0.f, 0.f, 0.f) & 255u); } }
                __syncthreads();
            }
        }
        }
    }
    SEAM(5);
    if (IN(6)) {
        { OrderLru S{(const char*)XC, (const char*)WLRU, G, bx}; EpiLru E{XC, lru_ba, lru_bx, lru_lambda, AA, BB}; pg8::gemm_phase(lds, D, 256, S, E); }
        if (bx >= 576 - 2 * G) convert(R_W2A0, R_W2D0, (bx - (576 - 2 * G)) * NWAVES + wave, (G - (576 - 2 * G)) * NWAVES);
        for (int wt = gw; wt < 32 * 32 * 16; wt += NGW) { const int bh = wt >> 9, dvb = (wt >> 4) & 31, dkb = wt & 15;
            const int dv = dvb * 16 + (lane & 15), dk0 = dkb * 16 + (lane >> 4) * 4; const float g256 = fast_exp2(256.0f * log2gamma(bh & 7));
            f32x4 Sv = {0.f, 0.f, 0.f, 0.f}, uu[8];
#pragma unroll
            for (int c = 0; c < 8; ++c) { const u32x2 w = *(const u32x2*)((const bf16*)UT + (((size_t)bh * 8 + c) * 512 + dv) * 256 + dk0); uu[c] = (f32x4){bflo(w.x), bfhi(w.x), bflo(w.y), bfhi(w.y)}; }
#pragma unroll
            for (int c = 0; c < 8; ++c) { const size_t bhc = (size_t)bh * 8 + c;
                *(u32x2*)(BCAT + (bhc * 512 + dv) * 512 + 256 + dk0) = (u32x2){pk2(Sv[0], Sv[1]), pk2(Sv[2], Sv[3])};
                Sv = g256 * Sv + uu[c]; }
            float* o = out + O_RETP + ((size_t)bh * 256 + dk0) * 512 + dv;
            o[0] = Sv[0]; o[512] = Sv[1]; o[1024] = Sv[2]; o[1536] = Sv[3]; }
    }
    SEAM(6);
    if (IN(7)) {
        for (int it = gt; it < 2 * 65536; it += NGT) {
            if (it < 65536) { const int s = it >> 9, c4 = it & 511; const size_t r0 = (size_t)s * 64;
                f32x4 h = {0.f, 0.f, 0.f, 0.f}, P = {1.f, 1.f, 1.f, 1.f};
                for (int t0 = 0; t0 < 64; t0 += 8) { f32x4 av[8], bv[8];
#pragma unroll
                    for (int t = 0; t < 8; ++t) { const u32x2 wa = ((const u32x2*)AA)[(r0 + t0 + t) * 512 + c4], wb = ((const u32x2*)BB)[(r0 + t0 + t) * 512 + c4];
                        av[t] = (f32x4){1.0f - bflo(wa.x), 1.0f - bfhi(wa.x), 1.0f - bflo(wa.y), 1.0f - bfhi(wa.y)}; bv[t] = (f32x4){bflo(wb.x), bfhi(wb.x), bflo(wb.y), bfhi(wb.y)}; }
#pragma unroll
                    for (int t = 0; t < 8; ++t) { h = av[t] * h + bv[t]; P = P * av[t]; } }
                ((f32x4*)AGA)[(size_t)s * 512 + c4] = P; ((f32x4*)AGB)[(size_t)s * 512 + c4] = h;
            } else { const int b = (it - 65536) >> 9, c4 = it & 511; const size_t r0 = (size_t)MP + b * 8;
                f32x4 h = ((const f32x4*)state_lru)[(size_t)b * 512 + c4];
                f32x4 av[8], bv[8]; u32x2 gv[8];
#pragma unroll
                for (int t = 0; t < 8; ++t) { const u32x2 wa = ((const u32x2*)AA)[(r0 + t) * 512 + c4], wb = ((const u32x2*)BB)[(r0 + t) * 512 + c4]; gv[t] = ((const u32x2*)GA)[(r0 + t) * 512 + c4];
                    av[t] = (f32x4){1.0f - bflo(wa.x), 1.0f - bfhi(wa.x), 1.0f - bflo(wa.y), 1.0f - bfhi(wa.y)}; bv[t] = (f32x4){bflo(wb.x), bfhi(wb.x), bflo(wb.y), bfhi(wb.y)}; }
#pragma unroll
                for (int t = 0; t < 8; ++t) { h = av[t] * h + bv[t]; const u32x2 gw2 = gv[t];
                    ((u32x2*)OA)[(r0 + t) * 512 + c4] = (u32x2){pk2(h[0] * bflo(gw2.x), h[1] * bfhi(gw2.x)), pk2(h[2] * bflo(gw2.y), h[3] * bfhi(gw2.y))}; }
                ((f32x4*)(out + O_LRUS))[(size_t)b * 512 + c4] = h; }
        }
        { OrderO S{(const char*)ACAT, (const char*)BCAT, G, bx, vcu}; EpiO E{OF}; pg8::gemm_phase(lds, 512, 512, S, E); }
    }
    SEAM(7);
    if (IN(8)) {
        for (int it = gt; it < 65536; it += NGT) { const int s = it >> 9, c4 = it & 511, b = s >> 5; const size_t r0 = (size_t)s * 64;
            f32x4 carry = {0.f, 0.f, 0.f, 0.f};
#pragma unroll 8
            for (int sp = b * 32; sp < s; ++sp) carry = ((const f32x4*)AGA)[(size_t)sp * 512 + c4] * carry + ((const f32x4*)AGB)[(size_t)sp * 512 + c4];
            f32x4 h = carry;
#pragma unroll 1
            for (int t0 = 0; t0 < 64; t0 += 8) { f32x4 av[8], bv[8]; u32x2 gv[8];
#pragma unroll
                for (int t = 0; t < 8; ++t) { const u32x2 wa = ((const u32x2*)AA)[(r0 + t0 + t) * 512 + c4], wb = ((const u32x2*)BB)[(r0 + t0 + t) * 512 + c4]; gv[t] = ((const u32x2*)GA)[(r0 + t0 + t) * 512 + c4];
                    av[t] = (f32x4){1.0f - bflo(wa.x), 1.0f - bfhi(wa.x), 1.0f - bflo(wa.y), 1.0f - bfhi(wa.y)}; bv[t] = (f32x4){bflo(wb.x), bfhi(wb.x), bflo(wb.y), bfhi(wb.y)}; }
#pragma unroll
                for (int t = 0; t < 8; ++t) { h = av[t] * h + bv[t]; const u32x2 gw2 = gv[t];
                    ((u32x2*)OA)[(r0 + t0 + t) * 512 + c4] = (u32x2){pk2(h[0] * bflo(gw2.x), h[1] * bfhi(gw2.x)), pk2(h[2] * bflo(gw2.y), h[3] * bfhi(gw2.y))}; } }
            if ((s & 31) == 31) ((f32x4*)(out + O_LRUP))[(size_t)b * 512 + c4] = h; }
        const bool bal8 = (G == 256); const bool hv8 = vcu < 128;
        const int n8 = bal8 ? (hv8 ? 2 : 14) : (MP * NH / 4 + NGW - 1 - gw) / NGW, w8 = bal8 ? ((hv8 ? vcu : vcu - 128) * NWAVES + wave) : gw, b8 = bal8 ? (hv8 ? 0 : 2048) : 0, s8 = bal8 ? 1024 : NGW;
        for (int q8 = 0; q8 < n8; ++q8) { const int wi0 = (b8 + w8 + q8 * s8) * 4;
            f32x4 v0[4], v1[4]; u32x2 s0[4], s1[4];
#pragma unroll
            for (int q2 = 0; q2 < 4; ++q2) { const int wi = wi0 + q2, row = wi >> 3, hh = wi & 7; const size_t base = (size_t)row * VD + hh * 512;
                const u32x2 o0 = ((const u32x2*)(OF + base))[lane], o1 = ((const u32x2*)(OF + base))[64 + lane];
                v0[q2] = (f32x4){bflo(o0.x), bfhi(o0.x), bflo(o0.y), bfhi(o0.y)}; v1[q2] = (f32x4){bflo(o1.x), bfhi(o1.x), bflo(o1.y), bfhi(o1.y)}; s0[q2] = ((const u32x2*)(SG + base))[lane]; s1[q2] = ((const u32x2*)(SG + base))[64 + lane]; }
#pragma unroll
            for (int q2 = 0; q2 < 4; ++q2) { const int wi = wi0 + q2, row = wi >> 3, hh = wi & 7; const size_t base = (size_t)row * VD + hh * 512;
                const f32x4 a0 = v0[q2], a1 = v1[q2];
                const float ss = (a0[0] * a0[0] + a0[1] * a0[1]) + (a0[2] * a0[2] + a0[3] * a0[3]) + (a1[0] * a1[0] + a1[1] * a1[1]) + (a1[2] * a1[2] + a1[3] * a1[3]);
                const float rstd = 1.0f / sqrtf(wave_sum(ss) * (1.0f / 512.0f) + EPS);
                const f32x4 g0 = ((const f32x4*)(ret_norm + hh * 512))[lane], g1 = ((const f32x4*)(ret_norm + hh * 512))[64 + lane];
                const float rs8 = rstd * O8_SCALE;
#define O8C(x) __builtin_amdgcn_fmed3f((x), -440.0f, 440.0f)
                ((unsigned*)((unsigned char*)OB + base))[lane] = f2fp8x4(O8C(a0[0] * rs8 * g0[0] * bflo(s0[q2].x)), O8C(a0[1] * rs8 * g0[1] * bfhi(s0[q2].x)), O8C(a0[2] * rs8 * g0[2] * bflo(s0[q2].y)), O8C(a0[3] * rs8 * g0[3] * bfhi(s0[q2].y)));
                ((unsigned*)((unsigned char*)OB + base))[64 + lane] = f2fp8x4(O8C(a1[0] * rs8 * g1[0] * bflo(s1[q2].x)), O8C(a1[1] * rs8 * g1[1] * bfhi(s1[q2].x)), O8C(a1[2] * rs8 * g1[2] * bflo(s1[q2].y)), O8C(a1[3] * rs8 * g1[3] * bfhi(s1[q2].y)));
#undef O8C
            } }
    }
    SEAM(8);
    if (IN(9)) {
        float* slabA = UT; float* slabB = (float*)((bf16*)UT + (size_t)8 * MS * D);
        { pg8::SplitOrder S; S.init(OA, (size_t)256 * D * 2, WPA, (size_t)256 * D * 2, D / 64, G, bx); EpiGate<0> E{SA, (bf16*)TMP, nullptr, slabA, 1.0f}; pg8::gemm_phase(lds, D, D, S, E); }
        { pg8::SplitOrder S; S.init(OB, (size_t)256 * VD, WPB, (size_t)256 * VD, VD / 128, G, bx); EpiGate<1> E{SB, (bf16*)TMP, MG, slabB, 1.0f / (O8_SCALE * W8_SCALE)};
          pg8::gemm_phase<EpiGate<1>, pg8::SplitOrder, 1>(lds, VD / 2, VD / 2, S, E); }
        xcd_barrier(bar);
        for (int q = gw; q < 2 * MS; q += NGW) { const int r = q >> 1, j0 = (q & 1) * 2; const size_t ro = (size_t)(MP + r) * D;
#pragma unroll 1
            for (int j = j0; j < j0 + 2; ++j) { const int c8 = lane + 64 * j;
                f32x4 a0 = {0.f, 0.f, 0.f, 0.f}, a1 = a0, b0 = a0, b1 = a0;
#pragma unroll
                for (int k = 0; k < 8; ++k) { const u32x4 wa = *(const u32x4*)((const bf16*)slabA + ((size_t)k * MS + r) * D + 8 * c8), wb = *(const u32x4*)((const bf16*)slabB + ((size_t)k * MS + r) * D + 8 * c8);
                    a0 += (f32x4){bflo(wa.x), bfhi(wa.x), bflo(wa.y), bfhi(wa.y)}; a1 += (f32x4){bflo(wa.z), bfhi(wa.z), bflo(wa.w), bfhi(wa.w)};
                    b0 += (f32x4){bflo(wb.x), bfhi(wb.x), bflo(wb.y), bfhi(wb.y)}; b1 += (f32x4){bflo(wb.z), bfhi(wb.z), bflo(wb.w), bfhi(wb.w)}; }
                const u32x4 ga = *(const u32x4*)(SA + ro + 8 * c8), gb = *(const u32x4*)(SB + ro + 8 * c8);
                u32x4 w;
                w.x = cvt_pk_bf16(bflo(ga.x) * a0[0] + bflo(gb.x) * b0[0], bfhi(ga.x) * a0[1] + bfhi(gb.x) * b0[1]);
                w.y = cvt_pk_bf16(bflo(ga.y) * a0[2] + bflo(gb.y) * b0[2], bfhi(ga.y) * a0[3] + bfhi(gb.y) * b0[3]);
                w.z = cvt_pk_bf16(bflo(ga.z) * a1[0] + bflo(gb.z) * b1[0], bfhi(ga.z) * a1[1] + bfhi(gb.z) * b1[1]);
                w.w = cvt_pk_bf16(bflo(ga.w) * a1[2] + bflo(gb.w) * b1[2], bfhi(ga.w) * a1[3] + bfhi(gb.w) * b1[3]);
                *(u32x4*)(MG + ro + 8 * c8) = w; } }
    }
    SEAM(9);
    if (IN(10)) { pg8::SplitOrder S; S.init(MG, (size_t)256 * D * 2, WOUT, (size_t)256 * D * 2, D / 64, G, bx); EpiResid<true> E{X, X, 1.0f, SLAB, 1.0f}; pg8::gemm_phase(lds, D, D, S, E); }
    SEAM(10);
    if (IN(11)) { for (int k_ = 0; k_ < rnk_; ++k_) { const int m = ROWMAP(k_); if (m < MP) rms_row_q8<true>(X + (size_t)m * D, ffn2_norm, U8 + (size_t)m * D, RS + m, lane);
            else rms_row_slab_q8<true>(X + (size_t)m * D, (const float*)((const bf16*)SLAB + (size_t)(m - MP) * D), 1.0f, X + (size_t)m * D, ffn2_norm, U8 + (size_t)m * D, RS + m, lane); } }
    SEAM(11);
    if (IN(12)) { pg8::TileOrder S; S.init(U8, (size_t)256 * D, W2A, (size_t)256 * D, 36, 44, D / 128, G, bx); EpiSwigluQ8 E{(unsigned char*)HB, RS, (const unsigned*)(ctl + CW_CM2)}; pg8::gemm_phase<EpiSwigluQ8, pg8::TileOrder, 2>(lds, D / 2, D / 2, S, E);
        if (bx >= 1584 - 6 * 256) { const int wk = (bx - (1584 - 6 * 256)) * NWAVES + wave, nwk = (G - (1584 - 6 * 256)) * NWAVES;
            convert(R_W2D0, R_WIN0, wk, nwk); convert(R_WPG0, R_LRU0, wk, nwk); } }
    SEAM(12);
    if (IN(13)) { pg8::SplitOrder S; S.init(HB, (size_t)256 * FF, W2D, (size_t)256 * FF, FF / 128, G, bx); EpiResid<true> E{X, X, 0.5f / (H8_SCALE * W8_SCALE), SLAB, 1.0f / (H8_SCALE * W8_SCALE)}; pg8::gemm_phase<EpiResid<true>, pg8::SplitOrder, 1>(lds, FF / 2, FF / 2, S, E); }
    SEAM(13);
    if (IN(14)) { for (int k_ = 0; k_ < rnk_; ++k_) { const int m = ROWMAP(k_); if (m < MP) rms_row_q8<true>(X + (size_t)m * D, ple_norm, U8 + (size_t)m * D, RS + m, lane);
            else rms_row_slab_q8<true>(X + (size_t)m * D, (const float*)((const bf16*)SLAB + (size_t)(m - MP) * D), 0.5f, X + (size_t)m * D, ple_norm, U8 + (size_t)m * D, RS + m, lane); } }
    SEAM(14);
    if (IN(15)) {
        { pg8::TileOrder S; S.init(PEB, (size_t)256 * PLE * 2, WPP, (size_t)256 * PLE * 2, 36, 8, PLE / 64, G, bx); EpiStoreF32 E{(bf16*)TMP2}; pg8::gemm_phase(lds, PLE, PLE, S, E); }
        { pg8::SplitOrder S; S.init(U8, (size_t)256 * D, WPG, (size_t)256 * D, D / 128, G, bx); EpiPle E{ple_bg, (const bf16*)TMP2, X, SLAB, RS, (const unsigned*)(ctl + CW_CM4)};
          pg8::gemm_phase<EpiPle, pg8::SplitOrder, 2>(lds, D / 2, D / 2, S, E); }
    }
    SEAM(15);
    if (IN(16)) { for (int k_ = 0; k_ < rnk_; ++k_) { const int m = ROWMAP(k_); if (m < MP) rms_row_f32(X + (size_t)m * D, final_norm, out + O_Y + (size_t)m * D, lane);
            else rms_row_ple_f32(X + (size_t)m * D, (const float*)((const bf16*)SLAB + (size_t)(m - MP) * D), ple_bg, (const bf16*)TMP2 + (size_t)m * D, final_norm, out + O_Y + (size_t)m * D, lane); } }
#undef IN
#undef SEAM
}

#undef x_prompt
#undef x_sample
#undef p_prompt
#undef p_sample
#undef state_lru
#undef state_conv
#undef state_ret
#undef ffn1_norm
#undef mix_norm
#undef b_in
#undef conv_w
#undef conv_b
#undef lru_ba
#undef lru_bx
#undef lru_lambda
#undef ret_norm
#undef ffn2_norm
#undef ple_norm
#undef ple_bg
#undef final_norm
#undef out
#undef W1A
#undef W1D
#undef W2A
#undef W2D
#undef WIN
#undef WPA
#undef WPB
#undef WOUT
#undef WPG
#undef WPP
#undef WLRU
#undef COS
#undef SIN
#undef U
#undef HB
#undef X
#undef XA
#undef SLAB
#undef GA
#undef Qb
#undef Kb
#undef ACAT
#undef BCAT
#undef KTD
#undef VTS
#undef SG
#undef SA
#undef SB
#undef XC
#undef AA
#undef BB
#undef HL
#undef PC
#undef AGA
#undef AGB
#undef OA
#undef UT
#undef OF
#undef OB
#undef TMP
#undef TMP2
#undef MG
#undef PEB
#undef ROWMAP
#undef U8
#undef WIN8
#undef RS
extern "C" void kernel_launch(void* const* d_in, const int* in_sizes, int n_in, void* d_out, int out_size, void* d_ws, size_t ws_size, hipStream_t stream) {
    static int grid = 0;
    if (grid == 0) {
        if (n_in != 34 || (size_t)out_size != O_END || ws_size < WS_END) { fprintf(stderr, "kernel_launch: unexpected shapes: n_in %d out %d ws %zu (need %zu)\n", n_in, out_size, ws_size, (size_t)WS_END); grid = -1; return; }
        int dev = 0, cus = 0, per_cu = 0;
        if (hipGetDevice(&dev) != hipSuccess || hipDeviceGetAttribute(&cus, hipDeviceAttributeMultiprocessorCount, dev) != hipSuccess) { grid = -1; return; }
        if (hipFuncSetAttribute((const void*)mega_fwd, hipFuncAttributeMaxDynamicSharedMemorySize, LDS_BYTES) != hipSuccess) { fprintf(stderr, "kernel_launch: hipFuncSetAttribute failed\n"); grid = -1; return; }
        if (hipOccupancyMaxActiveBlocksPerMultiprocessor(&per_cu, (const void*)mega_fwd, NWAVES * 64, LDS_BYTES) != hipSuccess || per_cu < 1) fprintf(stderr, "kernel_launch: occupancy query reports %d\n", per_cu);
        (void)hipGetLastError();
        grid = cus;
    }
    if (grid < 0) return;
    if (hipMemsetAsync((char*)d_ws + WS_CTL, 0, CTL_ZERO_BYTES, stream) != hipSuccess) return;
    Args a{};
    for (int i = 0; i < 34; ++i) a.in[i] = (const float*)d_in[i];
    a.out = (float*)d_out; a.ws = (unsigned char*)d_ws;
    a.ph_lo = 0; a.ph_hi = NPHASE;
    hipLaunchKernelGGL(mega_fwd, dim3(grid), dim3(NWAVES * 64), LDS_BYTES, stream, a);
}
```

```cpp
#include <hip/hip_runtime.h>
#include <cstdio>
#include <cstdint>

#define LAS __attribute__((address_space(3)))
#define GAS __attribute__((address_space(1)))
typedef unsigned short bf16;
typedef short bf16x8 __attribute__((ext_vector_type(8)));
typedef float f32x4 __attribute__((ext_vector_type(4)));
typedef float f32x2 __attribute__((ext_vector_type(2)));
typedef unsigned u32x4 __attribute__((ext_vector_type(4)));
typedef unsigned u32x2 __attribute__((ext_vector_type(2)));
typedef GAS unsigned gu32;

constexpr int D = 2048, FF = 5632, NIN = 20480, MP = 8192, MS = 1024, M = MP + MS, TP = 2048, NBS = 128, NH = 8, DK = 256, DV = 512, VD = 4096, PLE = 256;
constexpr float EPS = 1e-6f;
constexpr int NWAVES = 8;

constexpr size_t O_Y = 0, O_LRUP = 18874368, O_CONVP = 18882560, O_RETP = 18907136, O_LRUS = 23101440, O_CONVS = 23363584, O_RETS = 24150016, O_END = 158367744;

constexpr size_t MiB = 1u << 20;
constexpr size_t WS_CTL = 0, CTL_ZERO_BYTES = 1 * MiB;
constexpr size_t WS_W1A = 1 * MiB;
constexpr size_t WS_W1D = WS_W1A + 44 * MiB;
constexpr size_t WS_W2A = WS_W1D + 22 * MiB;
constexpr size_t WS_W2D = WS_W2A + 44 * MiB;
constexpr size_t WS_WIN = WS_W2D + 22 * MiB;
constexpr size_t WS_WPA = WS_WIN + 80 * MiB;
constexpr size_t WS_WPB = WS_WPA + 8 * MiB;
constexpr size_t WS_WOUT = WS_WPB + 16 * MiB;
constexpr size_t WS_WPG = WS_WOUT + 8 * MiB;
constexpr size_t WS_WPP = WS_WPG + 8 * MiB;
constexpr size_t WS_WLRU = WS_WPP + 1 * MiB;
constexpr size_t WS_COS = WS_WLRU + 2 * MiB;
constexpr size_t WS_SIN = WS_COS + 2 * MiB;
constexpr size_t WS_U = WS_SIN + 2 * MiB;
constexpr size_t WS_HB = WS_U + 36 * MiB;
constexpr size_t WS_X = WS_HB + 99 * MiB;
constexpr size_t WS_XA = WS_X + 72 * MiB;
constexpr size_t WS_GA = WS_XA + 72 * MiB;
constexpr size_t WS_Q = WS_GA + 36 * MiB;
constexpr size_t WS_K = WS_Q + 36 * MiB;
constexpr size_t WS_ACAT = WS_K + 36 * MiB;
constexpr size_t WS_BCAT = WS_ACAT + 64 * MiB;
constexpr size_t WS_KTD = WS_BCAT + 128 * MiB;
constexpr size_t WS_VTS = WS_KTD + 32 * MiB;
constexpr size_t WS_SG = WS_VTS + 8 * MiB;
constexpr size_t WS_SA = WS_SG + 72 * MiB;
constexpr size_t WS_SB = WS_SA + 36 * MiB;
constexpr size_t WS_XC = WS_SB + 36 * MiB;
constexpr size_t WS_AA = WS_XC + 36 * MiB;
constexpr size_t WS_BB = WS_AA + 72 * MiB;
constexpr size_t WS_HL = WS_BB + 72 * MiB;
constexpr size_t WS_PC = WS_HL + 32 * MiB;
constexpr size_t WS_AGA = WS_PC + 32 * MiB;
constexpr size_t WS_AGB = WS_AGA + 1 * MiB;
constexpr size_t WS_OA = WS_AGB + 1 * MiB;
constexpr size_t WS_UT = WS_OA + 36 * MiB;
constexpr size_t WS_OF = WS_UT + 128 * MiB;
constexpr size_t WS_OB = WS_OF + 128 * MiB;
constexpr size_t WS_TMP = WS_OB + 72 * MiB;
constexpr size_t WS_TMP2 = WS_TMP + 72 * MiB;
constexpr size_t WS_MG = WS_TMP2 + 72 * MiB;
constexpr size_t WS_PE = WS_MG + 36 * MiB;
constexpr size_t WS_U8 = WS_PE + 5 * MiB;
constexpr size_t WS_WIN8 = WS_U8 + 19 * MiB;
constexpr size_t WS_RS = WS_WIN8 + 40 * MiB;
constexpr size_t WS_END = WS_RS + 1 * MiB;

constexpr int CW_CM1 = 65536, CW_CM2 = CW_CM1 + 2 * FF, CW_CM3 = CW_CM2 + 2 * FF, CW_CM4 = CW_CM3 + NIN;
constexpr int CW_BAR = 4096;

constexpr int RING_BYTES = 131072, LDSCTL_OFF = RING_BYTES, MISC_OFF = LDSCTL_OFF + 320, XPOSE_OFF = RING_BYTES + 2048, LDS_BYTES = 147456;

#define RLX_AGENT __ATOMIC_RELAXED, __HIP_MEMORY_SCOPE_AGENT
#define LDS_WAIT() asm volatile("s_waitcnt lgkmcnt(0)" ::: "memory")
#define VM_WAIT() asm volatile("s_waitcnt vmcnt(0)" ::: "memory")
__device__ __forceinline__ unsigned f2bf(float f) { unsigned u = __builtin_bit_cast(unsigned, f); return (u + 0x7fffu + ((u >> 16) & 1u)) >> 16; }
__device__ __forceinline__ unsigned pk2(float lo, float hi) { return f2bf(lo) | (f2bf(hi) << 16); }
__device__ __forceinline__ float bflo(unsigned w) { return __builtin_bit_cast(float, w << 16); }
__device__ __forceinline__ float bfhi(unsigned w) { return __builtin_bit_cast(float, w & 0xffff0000u); }
__device__ __forceinline__ float bf1(bf16 v) { return __builtin_bit_cast(float, ((unsigned)v) << 16); }
typedef __bf16 bf16x2_t __attribute__((ext_vector_type(2)));
__device__ __forceinline__ unsigned cvt_pk_bf16(float lo, float hi) { const f32x2 v = {lo, hi}; const bf16x2_t b = __builtin_convertvector(v, bf16x2_t); return __builtin_bit_cast(unsigned, b); }
typedef int v8i __attribute__((ext_vector_type(8)));
typedef int v4i __attribute__((ext_vector_type(4)));
__device__ __forceinline__ unsigned f2fp8x4(float a, float b, float c, float d) { int w = 0; w = __builtin_amdgcn_cvt_pk_fp8_f32(a, b, w, false); w = __builtin_amdgcn_cvt_pk_fp8_f32(c, d, w, true); return (unsigned)w; }
constexpr float H8_SCALE = 8.0f;
constexpr float O8_SCALE = 8.0f;
constexpr float W8_SCALE = 64.0f;
__device__ __forceinline__ float fast_exp2(float x) { return __builtin_amdgcn_exp2f(x); }
__device__ __forceinline__ float fast_rcp(float x) { return __builtin_amdgcn_rcpf(x); }
__device__ __forceinline__ float sigmoidf_(float x) { return fast_rcp(1.0f + fast_exp2(-1.44269504089f * x)); }
__device__ __forceinline__ float siluf_(float x) { return x * sigmoidf_(x); }
__device__ __forceinline__ float gelu_tanh_(float x) { const float u = 0.7978845608028654f * (x + 0.044715f * x * x * x); return x * fast_rcp(1.0f + fast_exp2(-2.88539008178f * u)); }
#define DPPF(old, x, ctrl, rmask) __builtin_bit_cast(float, __builtin_amdgcn_update_dpp(__builtin_bit_cast(int, (float)(old)), __builtin_bit_cast(int, (float)(x)), (ctrl), (rmask), 0xf, false))
__device__ __forceinline__ float wave_sum(float v) {
    v += DPPF(0.f, v, 0xB1, 0xf); v += DPPF(0.f, v, 0x4E, 0xf); v += DPPF(0.f, v, 0x141, 0xf); v += DPPF(0.f, v, 0x140, 0xf);
    v += DPPF(0.f, v, 0x142, 0xa); v += DPPF(0.f, v, 0x143, 0xc);
    return __builtin_bit_cast(float, __builtin_amdgcn_readlane(__builtin_bit_cast(int, v), 63));
}
__device__ __forceinline__ float wave_max(float v) {
    v = fmaxf(v, DPPF(v, v, 0xB1, 0xf)); v = fmaxf(v, DPPF(v, v, 0x4E, 0xf)); v = fmaxf(v, DPPF(v, v, 0x141, 0xf)); v = fmaxf(v, DPPF(v, v, 0x140, 0xf));
    v = fmaxf(v, DPPF(v, v, 0x142, 0xa)); v = fmaxf(v, DPPF(v, v, 0x143, 0xc));
    return __builtin_bit_cast(float, __builtin_amdgcn_readlane(__builtin_bit_cast(int, v), 63));
}
__device__ __forceinline__ unsigned f2i8x4(float a, float b, float c, float d) {
    const int ia = (int)rintf(a), ib = (int)rintf(b), ic = (int)rintf(c), id = (int)rintf(d);
    return (unsigned)(ia & 255) | ((unsigned)(ib & 255) << 8) | ((unsigned)(ic & 255) << 16) | ((unsigned)id << 24); }
__device__ __forceinline__ float log2gamma(int hh) { return log1pf(-exp2f(-5.0f - (float)hh)) * 1.4426950408889634f; }

namespace pg8 {
constexpr int BM = 256, BK = 64, HALF = 128, HTB = HALF * BK * 2, STAGE_BYTES = 8 * HTB;
__host__ __device__ __forceinline__ int lds_byte(int r, int c) { const int st = (r >> 4) * 2 + (c >> 5), rr = r & 15, cc = c & 31, ob = rr * 64 + cc * 2; return st * 1024 + (ob ^ (((ob >> 9) & 1) << 5)); }
__host__ __device__ __forceinline__ void stage_rc(int b, int& R, int& C) { const int st = b / 1024, sb = b % 1024, swz = sb ^ (((sb >> 9) & 1) << 5); R = (st >> 1) * 16 + swz / 64; C = (st & 1) * 32 + (swz % 64) / 2; }
__host__ __device__ __forceinline__ int perm32(int rho) { const int n = rho >> 4, i = rho & 15; return 8 * (i >> 2) + 4 * n + (i & 3); }

struct Unit { const char* a; const char* b; int pm, pn, nt, ks; };

template <class Epi, class Sched, int MODE = 0>
__device__ __forceinline__ void gemm_phase(LAS unsigned char* lds, const int lda, const int ldb, const Sched& S, const Epi& E) {
    int tid = threadIdx.x; asm volatile("" : "+v"(tid));
    const int wid = __builtin_amdgcn_readfirstlane(tid >> 6), lane = tid & 63, wr = wid >> 2, wc = wid & 3, fr = lane & 15, fq = lane >> 4;
    unsigned voffA[2], voffB[2];
#pragma unroll
    for (int i = 0; i < 2; ++i) { int R, C; stage_rc(tid * 16 + i * 8192, R, C); const int Rb = (R & ~31) + perm32(R & 31);
        voffA[i] = (unsigned)(R * lda + C) * 2u; voffB[i] = (unsigned)(Rb * ldb + C) * 2u; }
    const size_t kstep = (size_t)(BK * 2);
    const size_t hstepA = (size_t)HALF * lda * 2, hstepB = (size_t)HALF * ldb * 2;
    const unsigned ldsw = (unsigned)wid * 1024u;
    const int aoff = lds_byte(wr * 64 + fr, fq * 8), boff = lds_byte(wc * 32 + fr, fq * 8);
#define PG8_SA(b, h) (((b) * 2 + (h)) * HTB)
#define PG8_SB(b, h) ((4 + (b) * 2 + (h)) * HTB)
#define PG8_STAGE(bufoff, gbase, voff) do { _Pragma("unroll") for (int _i = 0; _i < 2; ++_i) \
        __builtin_amdgcn_global_load_lds((const unsigned*)((const char*)(gbase) + (voff)[_i]), (LAS unsigned*)(lds + (bufoff) + ldsw + _i * 8192), 16, 0, 0); } while (0)
#define PG8_LDA(dst, b, h) do { _Pragma("unroll") for (int m = 0; m < 4; ++m) _Pragma("unroll") for (int k = 0; k < 2; ++k) dst[m][k] = *(const LAS bf16x8*)(lds + PG8_SA(b, h) + aoff + m * 2048 + k * 1024); } while (0)
#define PG8_LDB(dst, b, h) do { _Pragma("unroll") for (int n = 0; n < 2; ++n) _Pragma("unroll") for (int k = 0; k < 2; ++k) dst[n][k] = *(const LAS bf16x8*)(lds + PG8_SB(b, h) + boff + n * 2048 + k * 1024); } while (0)
#define PG8_CAT(x0, x1) __builtin_shufflevector(__builtin_bit_cast(v4i, x0), __builtin_bit_cast(v4i, x1), 0, 1, 2, 3, 4, 5, 6, 7)
#define PG8_MMA(ai, bj, At, Bt) do { __builtin_amdgcn_s_setprio(1); _Pragma("unroll") for (int m = 0; m < 4; ++m) _Pragma("unroll") for (int n = 0; n < 2; ++n) { \
        if constexpr (MODE == 1) asm volatile("v_mfma_scale_f32_16x16x128_f8f6f4 %0, %1, %2, %0, %3, %3 op_sel_hi:[0,0,0]" : "+v"(acc[ai][bj][m][n]) : "v"(PG8_CAT(Bt[n][0], Bt[n][1])), "v"(PG8_CAT(At[m][0], At[m][1])), "v"(sc8)); \
        else if constexpr (MODE == 2) { _Pragma("unroll") for (int k = 0; k < 2; ++k) acc[ai][bj][m][n] = __builtin_bit_cast(f32x4, __builtin_amdgcn_mfma_i32_16x16x64_i8(__builtin_bit_cast(v4i, Bt[n][k]), __builtin_bit_cast(v4i, At[m][k]), __builtin_bit_cast(v4i, acc[ai][bj][m][n]), 0, 0, 0)); } \
        else { _Pragma("unroll") for (int k = 0; k < 2; ++k) acc[ai][bj][m][n] = __builtin_amdgcn_mfma_f32_16x16x32_bf16(Bt[n][k], At[m][k], acc[ai][bj][m][n], 0, 0, 0); } } \
        __builtin_amdgcn_s_setprio(0); } while (0)
#define PG8_WAIT_V(n) asm volatile("s_waitcnt vmcnt(" #n ")" ::: "memory")
#define PG8_WAIT_L(n) asm volatile("s_waitcnt lgkmcnt(" #n ")" ::: "memory")
#define PG8_BAR __builtin_amdgcn_s_barrier()
#define PG8_SCHED __builtin_amdgcn_sched_barrier(0)
    Unit cur, nxt; int ui = 0;
    if (!S.next(0, cur)) return;
    [[maybe_unused]] int sc8 = 0x7F7F7F7F;
    f32x4 acc[2][2][4][2];
#pragma unroll
    for (int a = 0; a < 2; ++a)
#pragma unroll
        for (int b = 0; b < 2; ++b)
#pragma unroll
            for (int m = 0; m < 4; ++m)
#pragma unroll
                for (int n = 0; n < 2; ++n) acc[a][b][m][n] = (f32x4){0.f, 0.f, 0.f, 0.f};
    bf16x8 At[4][2], B0[2][2], B1[2][2];
    const char* cA = cur.a; const char* cB = cur.b;
    PG8_STAGE(PG8_SB(0, 0), cB, voffB); PG8_STAGE(PG8_SB(0, 1), cB + hstepB, voffB); PG8_STAGE(PG8_SA(0, 0), cA, voffA); PG8_STAGE(PG8_SA(0, 1), cA + hstepA, voffA);
    if (wr == 1) PG8_BAR;
    PG8_WAIT_V(2); PG8_BAR;
    PG8_STAGE(PG8_SB(1, 0), cB + kstep, voffB); PG8_STAGE(PG8_SA(1, 0), cA + kstep, voffA); PG8_STAGE(PG8_SB(1, 1), cB + hstepB + kstep, voffB);
    PG8_WAIT_V(6); PG8_BAR;
    for (;;) {
        const bool has_next = S.next(ui + 1, nxt);
        const char* nA = has_next ? nxt.a : cA; const char* nB = has_next ? nxt.b : cB;
        int nt = cur.nt; asm volatile("" : "+s"(nt));
        for (int t = 0; t < nt; t += 2) {
            const bool last = (t == nt - 2);
            const char* a1 = cA + (size_t)(t + 1) * kstep;
            const char* a2 = last ? nA : cA + (size_t)(t + 2) * kstep; const char* b2 = last ? nB : cB + (size_t)(t + 2) * kstep;
            const char* a3 = a2 + kstep; const char* b3 = b2 + kstep;
            PG8_LDB(B0, 0, 0); PG8_LDB(B1, 0, 1); PG8_SCHED; PG8_LDA(At, 0, 0); PG8_STAGE(PG8_SA(1, 1), a1 + hstepA, voffA);
            PG8_WAIT_V(8); PG8_WAIT_L(0); PG8_BAR; PG8_MMA(0, 0, At, B0); PG8_MMA(0, 1, At, B1); PG8_BAR; PG8_SCHED;
            PG8_LDA(At, 0, 1); PG8_STAGE(PG8_SB(0, 0), b2, voffB); PG8_STAGE(PG8_SB(0, 1), b2 + hstepB, voffB); PG8_STAGE(PG8_SA(0, 0), a2, voffA);
            PG8_WAIT_V(8); PG8_WAIT_L(0); PG8_BAR; PG8_MMA(1, 0, At, B0); PG8_MMA(1, 1, At, B1); PG8_BAR; PG8_SCHED;
            PG8_LDB(B0, 1, 0); PG8_LDB(B1, 1, 1); PG8_SCHED; PG8_LDA(At, 1, 0); PG8_STAGE(PG8_SA(0, 1), a2 + hstepA, voffA);
            PG8_WAIT_V(8); PG8_WAIT_L(0); PG8_BAR; PG8_MMA(0, 0, At, B0); PG8_MMA(0, 1, At, B1); PG8_BAR; PG8_SCHED;
            PG8_LDA(At, 1, 1); PG8_STAGE(PG8_SB(1, 0), b3, voffB); PG8_STAGE(PG8_SB(1, 1), b3 + hstepB, voffB); PG8_STAGE(PG8_SA(1, 0), a3, voffA);
            PG8_WAIT_V(8); PG8_WAIT_L(0); PG8_BAR; PG8_MMA(1, 0, At, B0); PG8_MMA(1, 1, At, B1); PG8_BAR; PG8_SCHED;
        }
        if (wr == 0) PG8_BAR;
        if constexpr (MODE == 1) asm volatile("s_nop 15\n\ts_nop 7" ::: "memory");
        E(acc, cur, wr, wc, fr, fq);
        if (!has_next) break;
#pragma unroll
        for (int a = 0; a < 2; ++a)
#pragma unroll
            for (int b = 0; b < 2; ++b)
#pragma unroll
                for (int m = 0; m < 4; ++m)
#pragma unroll
                    for (int n = 0; n < 2; ++n) acc[a][b][m][n] = (f32x4){0.f, 0.f, 0.f, 0.f};
        cur = nxt; cA = nA; cB = nB; ++ui;
        if (wr == 1) PG8_BAR;
    }
    PG8_WAIT_V(0);
    PG8_BAR;
#undef PG8_SA
#undef PG8_SB
#undef PG8_STAGE
#undef PG8_LDA
#undef PG8_LDB
#undef PG8_MMA
#undef PG8_CAT
#undef PG8_WAIT_V
#undef PG8_WAIT_L
#undef PG8_BAR
#undef PG8_SCHED
}

struct TileOrder {
    const char* A; const char* B; size_t strideA, strideB; int nM, nN, nwg, G, c, nt; int pn_s1 = 1 << 30, pn_s2 = 1 << 30, pn_a = 0, pn_b = 0, pn_c = 0;
    __device__ __forceinline__ void init(const void* A_, size_t sA, const void* B_, size_t sB, int nM_, int nN_, int nt_, int G_, int c_) { A = (const char*)A_; B = (const char*)B_; strideA = sA; strideB = sB; nM = nM_; nN = nN_; nwg = nM * nN; nt = nt_; G = G_; c = c_; }
    __device__ __forceinline__ bool next(int i, Unit& u) const {
        const int L = i * G + c; if (L >= nwg) return false;
        int wgid = L; { const int q = nwg / 8, r = nwg % 8, xcd = wgid % 8, off = wgid / 8; wgid = (xcd < r ? xcd * (q + 1) : r * (q + 1) + (xcd - r) * q) + off; }
        const int nig = 8 * nN, gid = wgid / nig, fm = gid * 8, gsz = (nM - fm) < 8 ? (nM - fm) : 8;
        u.pm = fm + ((wgid % nig) % gsz); { const int idx = (wgid % nig) / gsz; u.pn = idx < pn_s1 ? pn_a + idx : (idx < pn_s2 ? pn_b + idx - pn_s1 : pn_c + idx - pn_s2); }
        u.a = A + (size_t)u.pm * strideA; u.b = B + (size_t)u.pn * strideB; u.nt = nt; u.ks = -1; return true;
    }
};
struct SplitOrder {
    const char* A; const char* B; size_t strideA, strideB; int KT, G, c;
    __device__ __forceinline__ void init(const void* A_, size_t sA, const void* B_, size_t sB, int KT_, int G_, int c_) { A = (const char*)A_; B = (const char*)B_; strideA = sA; strideB = sB; KT = KT_; G = G_; c = c_; }
    __device__ __forceinline__ bool next(int i, Unit& u) const {
        const int L = i * G + c; if (L >= 512) return false;
        if (L < 256) { const int wgid = (L % 8) * 32 + L / 8;
            const int gid = wgid / 64, w = wgid % 64; u.pm = gid * 8 + (w % 8); u.pn = w / 8; u.nt = KT; u.ks = -1;
            u.a = A + (size_t)u.pm * strideA; u.b = B + (size_t)u.pn * strideB; return true; }
        const int sidx = L - 256, su = sidx >> 3, ks = sidx & 7; u.pm = 32 + (su & 3); u.pn = su >> 2; u.ks = ks;
        int kt0; if (KT == 88) { u.nt = (ks & 1) ? 10 : 12; kt0 = (ks >> 1) * 22 + (ks & 1) * 12; } else if (KT == 44) { u.nt = ks < 6 ? 6 : 4; kt0 = ks < 6 ? ks * 6 : 36 + (ks - 6) * 4; } else { u.nt = KT / 8; kt0 = ks * u.nt; }
        u.a = A + (size_t)u.pm * strideA + (size_t)kt0 * 128; u.b = B + (size_t)u.pn * strideB + (size_t)kt0 * 128; return true;
    }
};
}
using pg8::Unit;

#define EPI_ARGS const f32x4 (&acc)[2][2][4][2], const Unit& u, int wr, int wc, int fr, int fq
#define EPI_OPAQUE() asm volatile("" : "+v"(fr), "+v"(fq))
#define FOR_AI_M _Pragma("unroll") for (int ai = 0; ai < 2; ++ai) _Pragma("unroll") for (int m = 0; m < 4; ++m) if ((__builtin_amdgcn_sched_barrier(0), true))

#define FOR_AI_M_FREE _Pragma("unroll") for (int ai = 0; ai < 2; ++ai) _Pragma("unroll") for (int m = 0; m < 4; ++m)
struct EpiSwiglu {
    bf16* H;
    __device__ __forceinline__ void operator()(EPI_ARGS) const { EPI_OPAQUE();
        const int col0 = u.pn * 128 + wc * 32 + 8 * fq;
        FOR_AI_M { const int row = u.pm * 256 + ai * 128 + wr * 64 + m * 16 + fr;
            float o[8];
#pragma unroll
            for (int n = 0; n < 2; ++n)
#pragma unroll
                for (int j = 0; j < 4; ++j) o[4 * n + j] = siluf_(acc[ai][0][m][n][j]) * acc[ai][1][m][n][j];
            u32x4 w; w.x = cvt_pk_bf16(o[0], o[1]); w.y = cvt_pk_bf16(o[2], o[3]); w.z = cvt_pk_bf16(o[4], o[5]); w.w = cvt_pk_bf16(o[6], o[7]);
            *(u32x4*)(H + (size_t)row * FF + col0) = w; }
    }
};
struct EpiSwigluQ8 {
    unsigned char* H; const float* rs; const unsigned* cm;
    __device__ __forceinline__ void operator()(EPI_ARGS) const { EPI_OPAQUE();
        const int col0 = u.pn * 128 + wc * 32 + 8 * fq;
        float sg[8], su[8];
#pragma unroll
        for (int e = 0; e < 8; ++e) { sg[e] = __uint_as_float(cm[u.pn * 256 + wc * 32 + 8 * fq + e]) * (1.0f / 127.0f); su[e] = __uint_as_float(cm[u.pn * 256 + 128 + wc * 32 + 8 * fq + e]) * (1.0f / 127.0f); }
        float sav[2][4];
#pragma unroll
        for (int ai = 0; ai < 2; ++ai)
#pragma unroll
            for (int m = 0; m < 4; ++m) sav[ai][m] = rs[u.pm * 256 + ai * 128 + wr * 64 + m * 16 + fr];
        FOR_AI_M_FREE { const int row = u.pm * 256 + ai * 128 + wr * 64 + m * 16 + fr; const float sa = sav[ai][m];
            float o[8];
#pragma unroll
            for (int n = 0; n < 2; ++n)
#pragma unroll
                for (int j = 0; j < 4; ++j) { const float fg = acc[ai][0][m][n][j], fu = acc[ai][1][m][n][j];
                    const float g = (float)__float_as_int(fg) * (sa * sg[4 * n + j]), uu = (float)__float_as_int(fu) * (sa * su[4 * n + j]);
                    o[4 * n + j] = __builtin_amdgcn_fmed3f(siluf_(g) * uu * H8_SCALE, -440.0f, 440.0f); }
            u32x2 w; w.x = f2fp8x4(o[0], o[1], o[2], o[3]); w.y = f2fp8x4(o[4], o[5], o[6], o[7]);
            *(u32x2*)(H + (size_t)row * FF + col0) = w; }
    }
};
template <bool INBF> struct EpiResid {
    const void* inP; bf16* out; float alpha; float* slab; float accs;
    __device__ __forceinline__ void operator()(EPI_ARGS) const { EPI_OPAQUE();
        if (u.ks >= 0) {
            bf16* o = (bf16*)slab + ((size_t)u.ks * MS + (size_t)(u.pm - 32) * 256) * D;
            FOR_AI_M { const int rl = ai * 128 + wr * 64 + m * 16 + fr;
#pragma unroll
                for (int bj = 0; bj < 2; ++bj) { const size_t off = (size_t)rl * D + u.pn * 256 + bj * 128 + wc * 32 + 8 * fq; const f32x4 a0 = acc[ai][bj][m][0] * accs, a1 = acc[ai][bj][m][1] * accs;
                    u32x4 w; w.x = cvt_pk_bf16(a0[0], a0[1]); w.y = cvt_pk_bf16(a0[2], a0[3]); w.z = cvt_pk_bf16(a1[0], a1[1]); w.w = cvt_pk_bf16(a1[2], a1[3]); *(u32x4*)(o + off) = w; } }
            return; }
        bf16* o = out + (size_t)u.pm * 256 * D;
        FOR_AI_M { const int rl = ai * 128 + wr * 64 + m * 16 + fr;
#pragma unroll
            for (int bj = 0; bj < 2; ++bj) { const size_t off = (size_t)rl * D + u.pn * 256 + bj * 128 + wc * 32 + 8 * fq; f32x4 x0, x1;
                if (INBF) { const u32x4 xw = *(const u32x4*)((const bf16*)inP + (size_t)u.pm * 256 * D + off); x0 = (f32x4){bflo(xw.x), bfhi(xw.x), bflo(xw.y), bfhi(xw.y)}; x1 = (f32x4){bflo(xw.z), bfhi(xw.z), bflo(xw.w), bfhi(xw.w)}; }
                else { const float* in = (const float*)inP + (size_t)u.pm * 256 * D + off; x0 = *(const f32x4*)in; x1 = *(const f32x4*)(in + 4); }
                const f32x4 r0 = x0 + alpha * acc[ai][bj][m][0], r1 = x1 + alpha * acc[ai][bj][m][1];
                u32x4 w; w.x = cvt_pk_bf16(r0[0], r0[1]); w.y = cvt_pk_bf16(r0[2], r0[3]); w.z = cvt_pk_bf16(r1[0], r1[1]); w.w = cvt_pk_bf16(r1[2], r1[3]); *(u32x4*)(o + off) = w; } }
    }
};
#define MIXV(ai, bj, m, n, j) (Q8 ? fmaf((float)__float_as_int(acc[ai][bj][m][n][j]), sa * sw[bj][n][j], bv[bj][n][j]) : acc[ai][bj][m][n][j] + bv[bj][n][j])
template <bool Q8> struct EpiMix {
    const float* bias; const float* cosT; const float* sinT;
    bf16 *XA, *GA, *Q, *K, *ACAT, *BCAT, *KTD, *VTS, *SG, *SA, *SB; LAS unsigned char* xl; const float* rs; const unsigned* cm;
    template <int ACT> __device__ __forceinline__ void plain_bf16(EPI_ARGS, bf16* O, int ldo, int ct) const {
        f32x4 bv[2][2], sw[2][2];
#pragma unroll
        for (int bj = 0; bj < 2; ++bj)
#pragma unroll
            for (int n = 0; n < 2; ++n) { bv[bj][n] = *(const f32x4*)(bias + u.pn * 256 + bj * 128 + wc * 32 + 8 * fq + 4 * n); if (Q8) { const u32x4 cw = *(const u32x4*)(cm + u.pn * 256 + bj * 128 + wc * 32 + 8 * fq + 4 * n); sw[bj][n] = (f32x4){__uint_as_float(cw.x), __uint_as_float(cw.y), __uint_as_float(cw.z), __uint_as_float(cw.w)} * (1.0f / 127.0f); } else sw[bj][n] = (f32x4){0.f, 0.f, 0.f, 0.f}; }
        float sav[2][4];
#pragma unroll
        for (int ai = 0; ai < 2; ++ai)
#pragma unroll
            for (int m = 0; m < 4; ++m) sav[ai][m] = Q8 ? rs[u.pm * 256 + ai * 128 + wr * 64 + m * 16 + fr] : 0.f;
        FOR_AI_M { const int row = u.pm * 256 + ai * 128 + wr * 64 + m * 16 + fr; const float sa = sav[ai][m];
#pragma unroll
            for (int bj = 0; bj < 2; ++bj) { float o[8];
#pragma unroll
                for (int n = 0; n < 2; ++n)
#pragma unroll
                    for (int j = 0; j < 4; ++j) { const float v = MIXV(ai, bj, m, n, j); o[4 * n + j] = ACT == 0 ? gelu_tanh_(v) : (ACT == 1 ? siluf_(v) : (ACT == 2 ? sigmoidf_(v) : v)); }
                u32x4 w; w.x = cvt_pk_bf16(o[0], o[1]); w.y = cvt_pk_bf16(o[2], o[3]); w.z = cvt_pk_bf16(o[4], o[5]); w.w = cvt_pk_bf16(o[6], o[7]);
                *(u32x4*)(O + (size_t)row * ldo + ct * 256 + bj * 128 + wc * 32 + 8 * fq) = w; } }
    }
    __device__ __forceinline__ void operator()(EPI_ARGS) const { EPI_OPAQUE();
        const int pn = u.pn;
        if (pn < 8) { plain_bf16<3>(acc, u, wr, wc, fr, fq, XA, D, pn);
        } else if (pn < 16) { plain_bf16<0>(acc, u, wr, wc, fr, fq, GA, D, pn - 8);
        } else if (pn < 32) {
            const bool isk = pn >= 24; const int hh = (pn - 16) & 7; const float l2g = log2gamma(hh);
            const bool prompt = u.pm < 32; const float ksc = isk ? 0.0625f : 1.0f;
            f32x4 bv[2][2], sw[2][2];
#pragma unroll
            for (int bj = 0; bj < 2; ++bj)
#pragma unroll
                for (int n = 0; n < 2; ++n) { bv[bj][n] = *(const f32x4*)(bias + pn * 256 + bj * 128 + wc * 32 + 8 * fq + 4 * n); if (Q8) { const u32x4 cw = *(const u32x4*)(cm + pn * 256 + bj * 128 + wc * 32 + 8 * fq + 4 * n); sw[bj][n] = (f32x4){__uint_as_float(cw.x), __uint_as_float(cw.y), __uint_as_float(cw.z), __uint_as_float(cw.w)} * (1.0f / 127.0f); } else sw[bj][n] = (f32x4){0.f, 0.f, 0.f, 0.f}; }
            bf16* QK = isk ? K : Q;
            float sav[2][4];
#pragma unroll
        for (int ai = 0; ai < 2; ++ai)
#pragma unroll
            for (int m = 0; m < 4; ++m) sav[ai][m] = Q8 ? rs[u.pm * 256 + ai * 128 + wr * 64 + m * 16 + fr] : 0.f;
            FOR_AI_M { const int rl = ai * 128 + wr * 64 + m * 16 + fr; const float sa = sav[ai][m];
                int tp; size_t rowbase;
                int bhc = 0;
                if (prompt) { const int b = u.pm >> 3, c = u.pm & 7; tp = c * 256 + rl; bhc = (b * 8 + hh) * 8 + c; rowbase = ((size_t)bhc * 256 + rl) * 256; }
                else { const int sr = (u.pm - 32) * 256 + rl, b = sr >> 3, t = sr & 7; tp = 2048 + t; rowbase = (size_t)32 * 2048 * 256 + ((size_t)(b * 8 + hh) * 8 + t) * 256; }
                float o1[8], o2[8];
#pragma unroll
                for (int n = 0; n < 2; ++n) { const f32x4 cv = *(const f32x4*)(cosT + (size_t)tp * 128 + wc * 32 + 8 * fq + 4 * n), sv = *(const f32x4*)(sinT + (size_t)tp * 128 + wc * 32 + 8 * fq + 4 * n);
#pragma unroll
                    for (int j = 0; j < 4; ++j) { const float x1 = MIXV(ai, 0, m, n, j), x2 = MIXV(ai, 1, m, n, j);
                        o1[4 * n + j] = (x1 * cv[j] - x2 * sv[j]) * ksc; o2[4 * n + j] = (x2 * cv[j] + x1 * sv[j]) * ksc; } }
                const int dk0 = wc * 32 + 8 * fq;
                u32x4 w1, w2; w1.x = cvt_pk_bf16(o1[0], o1[1]); w1.y = cvt_pk_bf16(o1[2], o1[3]); w1.z = cvt_pk_bf16(o1[4], o1[5]); w1.w = cvt_pk_bf16(o1[6], o1[7]);
                w2.x = cvt_pk_bf16(o2[0], o2[1]); w2.y = cvt_pk_bf16(o2[2], o2[3]); w2.z = cvt_pk_bf16(o2[4], o2[5]); w2.w = cvt_pk_bf16(o2[6], o2[7]);
                *(u32x4*)(QK + rowbase + dk0) = w1; *(u32x4*)(QK + rowbase + 128 + dk0) = w2;
                if (prompt) {
                    if (!isk) {
                        const float g = fast_exp2((float)(rl + 1) * l2g); bf16* p = ACAT + ((size_t)bhc * 256 + rl) * 512 + 256 + dk0;
                        u32x4 v1, v2; v1.x = cvt_pk_bf16(o1[0] * g, o1[1] * g); v1.y = cvt_pk_bf16(o1[2] * g, o1[3] * g); v1.z = cvt_pk_bf16(o1[4] * g, o1[5] * g); v1.w = cvt_pk_bf16(o1[6] * g, o1[7] * g);
                        v2.x = cvt_pk_bf16(o2[0] * g, o2[1] * g); v2.y = cvt_pk_bf16(o2[2] * g, o2[3] * g); v2.z = cvt_pk_bf16(o2[4] * g, o2[5] * g); v2.w = cvt_pk_bf16(o2[6] * g, o2[7] * g);
                        *(u32x4*)p = v1; *(u32x4*)(p + 128) = v2;
                    } else {
                        const float g = fast_exp2((float)(255 - rl) * l2g); LAS bf16* scr = (LAS bf16*)(xl + (wr * 4 + wc) * 1024); const int ln = fr + 16 * fq;
#pragma unroll
                        for (int hf = 0; hf < 2; ++hf) {
#pragma unroll
                            for (int e = 0; e < 8; ++e) scr[(8 * fq + e) * 16 + fr] = (bf16)f2bf((hf ? o2[e] : o1[e]) * g);
                            asm volatile("" ::: "memory");
                            const u32x4 w = *(const LAS u32x4*)(scr + (ln >> 1) * 16 + (ln & 1) * 8);
                            asm volatile("" ::: "memory");
                            *(u32x4*)(KTD + ((size_t)bhc * 256 + hf * 128 + wc * 32 + (ln >> 1)) * 256 + (rl - fr) + (ln & 1) * 8) = w; }
                    }
                }
            }
        } else if (pn < 48) {
            const int hh = (pn - 32) >> 1, half = (pn - 32) & 1; const bool prompt = u.pm < 32;
            f32x4 bv[2][2], sw[2][2];
#pragma unroll
            for (int bj = 0; bj < 2; ++bj)
#pragma unroll
                for (int n = 0; n < 2; ++n) { bv[bj][n] = *(const f32x4*)(bias + pn * 256 + bj * 128 + wc * 32 + 8 * fq + 4 * n); if (Q8) { const u32x4 cw = *(const u32x4*)(cm + pn * 256 + bj * 128 + wc * 32 + 8 * fq + 4 * n); sw[bj][n] = (f32x4){__uint_as_float(cw.x), __uint_as_float(cw.y), __uint_as_float(cw.z), __uint_as_float(cw.w)} * (1.0f / 127.0f); } else sw[bj][n] = (f32x4){0.f, 0.f, 0.f, 0.f}; }
            LAS bf16* scr = (LAS bf16*)(xl + (wr * 4 + wc) * 1024); const int ln = fr + 16 * fq;
            FOR_AI_M { const int rb = ai * 128 + wr * 64 + m * 16; const float sa = Q8 ? rs[u.pm * 256 + rb + fr] : 0.f;
                bf16* p; size_t es;
                if (prompt) { const int b = u.pm >> 3, c = u.pm & 7, bhc = (b * 8 + hh) * 8 + c; p = BCAT + (size_t)bhc * 512 * 512 + rb + (ln & 1) * 8; es = 512; }
                else { const int sr = (u.pm - 32) * 256 + rb, b = (sr >> 3) + (ln & 1); p = VTS + (size_t)(b * 8 + hh) * 512 * 8; es = 8; }
#pragma unroll
                for (int bj = 0; bj < 2; ++bj) {
#pragma unroll
                    for (int n = 0; n < 2; ++n)
#pragma unroll
                        for (int j = 0; j < 4; ++j) scr[(8 * fq + 4 * n + j) * 16 + fr] = (bf16)f2bf(MIXV(ai, bj, m, n, j));
                    asm volatile("" ::: "memory");
                    const u32x4 w = *(const LAS u32x4*)(scr + (ln >> 1) * 16 + (ln & 1) * 8);
                    asm volatile("" ::: "memory");
                    *(u32x4*)(p + (size_t)(half * 256 + bj * 128 + wc * 32 + (ln >> 1)) * es) = w; }
            }
        } else if (pn < 64) { plain_bf16<1>(acc, u, wr, wc, fr, fq, SG, VD, pn - 48);
        } else { plain_bf16<2>(acc, u, wr, wc, fr, fq, pn < 72 ? SA : SB, D, (pn - 64) & 7); }
    }
};
#undef MIXV
struct EpiLru {
    const bf16* XC; const float *ba, *bx, *lam; bf16 *AA, *BB;
    __device__ __forceinline__ void operator()(EPI_ARGS) const { EPI_OPAQUE();
        const int ch0 = (u.pn >> 1) * 256 + (u.pn & 1) * 128 + wc * 32 + 8 * fq;
        float vba[8], vbx[8], vsp[8];
#pragma unroll
        for (int e = 0; e < 8; ++e) { vba[e] = ba[ch0 + e]; vbx[e] = bx[ch0 + e]; vsp[e] = log1pf(expf(-lam[ch0 + e])); }
        FOR_AI_M { const int row = u.pm * 256 + ai * 128 + wr * 64 + m * 16 + fr;
            const bool first = (row < MP) && ((row & (TP - 1)) == 0);
            const u32x4 xw = *(const u32x4*)(XC + (size_t)row * D + ch0);
            const float xc[8] = {bflo(xw.x), bfhi(xw.x), bflo(xw.y), bfhi(xw.y), bflo(xw.z), bfhi(xw.z), bflo(xw.w), bfhi(xw.w)};
            float av[8], bvv[8];
#pragma unroll
            for (int n = 0; n < 2; ++n)
#pragma unroll
                for (int j = 0; j < 4; ++j) { const int e = 4 * n + j;
                    const float r = sigmoidf_(acc[ai][0][m][n][j] + vba[e]), gi = sigmoidf_(acc[ai][1][m][n][j] + vbx[e]);
                    const float la2 = -11.5415603271f * r * vsp[e];
                    const float a = fast_exp2(la2); float mult = __builtin_amdgcn_sqrtf(fmaxf(1.0f - a * a, 0.0f)); if (first) mult = 1.0f;
                    av[e] = 1.0f - a; bvv[e] = mult * gi * xc[e]; }
            u32x4 wa, wb; wa.x = cvt_pk_bf16(av[0], av[1]); wa.y = cvt_pk_bf16(av[2], av[3]); wa.z = cvt_pk_bf16(av[4], av[5]); wa.w = cvt_pk_bf16(av[6], av[7]);
            wb.x = cvt_pk_bf16(bvv[0], bvv[1]); wb.y = cvt_pk_bf16(bvv[2], bvv[3]); wb.z = cvt_pk_bf16(bvv[4], bvv[5]); wb.w = cvt_pk_bf16(bvv[6], bvv[7]);
            *(u32x4*)(AA + (size_t)row * D + ch0) = wa; *(u32x4*)(BB + (size_t)row * D + ch0) = wb; }
    }
};
struct EpiScores {
    bf16* ACAT;
    __device__ __forceinline__ void operator()(EPI_ARGS) const { EPI_OPAQUE();
        const int bhc = u.pm, hh = (bhc >> 3) & 7; const float l2g = log2gamma(hh);
        FOR_AI_M { const int i = ai * 128 + wr * 64 + m * 16 + fr;
#pragma unroll
            for (int bj = 0; bj < 2; ++bj) { const int j0 = bj * 128 + wc * 32 + 8 * fq; float o[8];
#pragma unroll
                for (int n = 0; n < 2; ++n)
#pragma unroll
                    for (int jj = 0; jj < 4; ++jj) { const float fd = (float)(i - (j0 + 4 * n + jj)); o[4 * n + jj] = acc[ai][bj][m][n][jj] * fast_exp2(fd * l2g - fmaxf(-fd, 0.0f) * 1000.0f); }
                u32x4 w; w.x = cvt_pk_bf16(o[0], o[1]); w.y = cvt_pk_bf16(o[2], o[3]); w.z = cvt_pk_bf16(o[4], o[5]); w.w = cvt_pk_bf16(o[6], o[7]);
                *(u32x4*)(ACAT + ((size_t)bhc * 256 + i) * 512 + j0) = w; }
            __builtin_amdgcn_sched_barrier(0); }
    }
};
struct EpiUT {
    bf16* UT;
    __device__ __forceinline__ void operator()(EPI_ARGS) const { EPI_OPAQUE();
        bf16* base = UT + ((size_t)u.pm * 512 + u.pn * 256) * 256;
        FOR_AI_M { const int rl = ai * 128 + wr * 64 + m * 16 + fr;
#pragma unroll
            for (int bj = 0; bj < 2; ++bj) { const f32x4 a0 = acc[ai][bj][m][0], a1 = acc[ai][bj][m][1];
                u32x4 w; w.x = cvt_pk_bf16(a0[0], a0[1]); w.y = cvt_pk_bf16(a0[2], a0[3]); w.z = cvt_pk_bf16(a1[0], a1[1]); w.w = cvt_pk_bf16(a1[2], a1[3]);
                *(u32x4*)(base + (size_t)rl * 256 + bj * 128 + wc * 32 + 8 * fq) = w; } }
    }
};
struct EpiO {
    bf16* OF;
    __device__ __forceinline__ void operator()(EPI_ARGS) const { EPI_OPAQUE();
        const int bhc = u.pm, b = bhc >> 6, hh = (bhc >> 3) & 7, c = bhc & 7;
        bf16* base = OF + ((size_t)b * TP + c * 256) * VD + hh * 512 + u.pn * 256;
        FOR_AI_M { const int rl = ai * 128 + wr * 64 + m * 16 + fr;
#pragma unroll
            for (int bj = 0; bj < 2; ++bj) { const f32x4 a0 = acc[ai][bj][m][0], a1 = acc[ai][bj][m][1];
                u32x4 w; w.x = cvt_pk_bf16(a0[0], a0[1]); w.y = cvt_pk_bf16(a0[2], a0[3]); w.z = cvt_pk_bf16(a1[0], a1[1]); w.w = cvt_pk_bf16(a1[2], a1[3]);
                *(u32x4*)(base + (size_t)rl * VD + bj * 128 + wc * 32 + 8 * fq) = w; } }
    }
};
__device__ __forceinline__ void slab_store(EPI_ARGS, float* slab, float accs = 1.0f) {
    bf16* o = (bf16*)slab + ((size_t)u.ks * MS + (size_t)(u.pm - 32) * 256) * D;
    FOR_AI_M { const int rl = ai * 128 + wr * 64 + m * 16 + fr;
#pragma unroll
        for (int bj = 0; bj < 2; ++bj) { const size_t off = (size_t)rl * D + u.pn * 256 + bj * 128 + wc * 32 + 8 * fq; const f32x4 a0 = acc[ai][bj][m][0] * accs, a1 = acc[ai][bj][m][1] * accs;
            u32x4 w; w.x = cvt_pk_bf16(a0[0], a0[1]); w.y = cvt_pk_bf16(a0[2], a0[3]); w.z = cvt_pk_bf16(a1[0], a1[1]); w.w = cvt_pk_bf16(a1[2], a1[3]); *(u32x4*)(o + off) = w; } }
}
template <int MODE> struct EpiGate {
    const bf16* G; bf16* T; bf16* O; float* slab; float accs;
    __device__ __forceinline__ void operator()(EPI_ARGS) const { EPI_OPAQUE();
        if (u.ks >= 0) { slab_store(acc, u, wr, wc, fr, fq, slab, accs); return; }
        FOR_AI_M { const int row = u.pm * 256 + ai * 128 + wr * 64 + m * 16 + fr;
#pragma unroll
            for (int bj = 0; bj < 2; ++bj) { const size_t off = (size_t)row * D + u.pn * 256 + bj * 128 + wc * 32 + 8 * fq;
                const u32x4 gw = *(const u32x4*)(G + off);
                const f32x4 g0 = (f32x4){bflo(gw.x), bfhi(gw.x), bflo(gw.y), bfhi(gw.y)} * accs, g1 = (f32x4){bflo(gw.z), bfhi(gw.z), bflo(gw.w), bfhi(gw.w)} * accs;
                if (MODE == 0) { const f32x4 p0 = g0 * acc[ai][bj][m][0], p1 = g1 * acc[ai][bj][m][1];
                    u32x4 w; w.x = cvt_pk_bf16(p0[0], p0[1]); w.y = cvt_pk_bf16(p0[2], p0[3]); w.z = cvt_pk_bf16(p1[0], p1[1]); w.w = cvt_pk_bf16(p1[2], p1[3]); *(u32x4*)(T + off) = w; }
                else { const u32x4 tw = *(const u32x4*)(T + off);
                    const f32x4 t0 = (f32x4){bflo(tw.x), bfhi(tw.x), bflo(tw.y), bfhi(tw.y)} + g0 * acc[ai][bj][m][0], t1 = (f32x4){bflo(tw.z), bfhi(tw.z), bflo(tw.w), bfhi(tw.w)} + g1 * acc[ai][bj][m][1];
                    u32x4 w; w.x = cvt_pk_bf16(t0[0], t0[1]); w.y = cvt_pk_bf16(t0[2], t0[3]); w.z = cvt_pk_bf16(t1[0], t1[1]); w.w = cvt_pk_bf16(t1[2], t1[3]);
                    *(u32x4*)(O + off) = w; } } }
    }
};
struct EpiStoreF32 {
    bf16* T;
    __device__ __forceinline__ void operator()(EPI_ARGS) const { EPI_OPAQUE();
        FOR_AI_M { const int row = u.pm * 256 + ai * 128 + wr * 64 + m * 16 + fr;
#pragma unroll
            for (int bj = 0; bj < 2; ++bj) { const f32x4 a0 = acc[ai][bj][m][0], a1 = acc[ai][bj][m][1];
                u32x4 w; w.x = cvt_pk_bf16(a0[0], a0[1]); w.y = cvt_pk_bf16(a0[2], a0[3]); w.z = cvt_pk_bf16(a1[0], a1[1]); w.w = cvt_pk_bf16(a1[2], a1[3]);
                *(u32x4*)(T + (size_t)row * D + u.pn * 256 + bj * 128 + wc * 32 + 8 * fq) = w; } }
    }
};
struct EpiPle {
    const float* bg; const bf16* T; bf16* X; float* slab; const float* rs; const unsigned* cm;
    __device__ __forceinline__ void operator()(EPI_ARGS) const { EPI_OPAQUE();
        f32x4 bv[2][2], sw[2][2];
#pragma unroll
        for (int bj = 0; bj < 2; ++bj)
#pragma unroll
            for (int n = 0; n < 2; ++n) { bv[bj][n] = *(const f32x4*)(bg + u.pn * 256 + bj * 128 + wc * 32 + 8 * fq + 4 * n); const u32x4 cw = *(const u32x4*)(cm + u.pn * 256 + bj * 128 + wc * 32 + 8 * fq + 4 * n);
                sw[bj][n] = (f32x4){__uint_as_float(cw.x), __uint_as_float(cw.y), __uint_as_float(cw.z), __uint_as_float(cw.w)} * (1.0f / 127.0f); }
        if (u.ks >= 0) {
            bf16* o = (bf16*)slab + ((size_t)u.ks * MS + (size_t)(u.pm - 32) * 256) * D;
            FOR_AI_M { const int rl = ai * 128 + wr * 64 + m * 16 + fr; const float sa = rs[u.pm * 256 + rl];
#pragma unroll
                for (int bj = 0; bj < 2; ++bj) { const size_t off = (size_t)rl * D + u.pn * 256 + bj * 128 + wc * 32 + 8 * fq; float p[8];
#pragma unroll
                    for (int n = 0; n < 2; ++n)
#pragma unroll
                        for (int j = 0; j < 4; ++j) p[4 * n + j] = (float)__float_as_int(acc[ai][bj][m][n][j]) * (sa * sw[bj][n][j]);
                    u32x4 w; w.x = cvt_pk_bf16(p[0], p[1]); w.y = cvt_pk_bf16(p[2], p[3]); w.z = cvt_pk_bf16(p[4], p[5]); w.w = cvt_pk_bf16(p[6], p[7]); *(u32x4*)(o + off) = w; } }
            return; }
        float sav[2][4];
#pragma unroll
        for (int ai = 0; ai < 2; ++ai)
#pragma unroll
            for (int m = 0; m < 4; ++m) sav[ai][m] = rs[u.pm * 256 + ai * 128 + wr * 64 + m * 16 + fr];
        FOR_AI_M { const int row = u.pm * 256 + ai * 128 + wr * 64 + m * 16 + fr; const float sa = sav[ai][m];
#pragma unroll
            for (int bj = 0; bj < 2; ++bj) { const size_t off = (size_t)row * D + u.pn * 256 + bj * 128 + wc * 32 + 8 * fq;
                const u32x4 tw = *(const u32x4*)(T + off), xw = *(const u32x4*)(X + off);
                const float t[8] = {bflo(tw.x), bfhi(tw.x), bflo(tw.y), bfhi(tw.y), bflo(tw.z), bfhi(tw.z), bflo(tw.w), bfhi(tw.w)}, x[8] = {bflo(xw.x), bfhi(xw.x), bflo(xw.y), bfhi(xw.y), bflo(xw.z), bfhi(xw.z), bflo(xw.w), bfhi(xw.w)};
                float o[8];
#pragma unroll
                for (int n = 0; n < 2; ++n)
#pragma unroll
                    for (int j = 0; j < 4; ++j) o[4 * n + j] = x[4 * n + j] + sigmoidf_(fmaf((float)__float_as_int(acc[ai][bj][m][n][j]), sa * sw[bj][n][j], bv[bj][n][j])) * t[4 * n + j];
                u32x4 w; w.x = cvt_pk_bf16(o[0], o[1]); w.y = cvt_pk_bf16(o[2], o[3]); w.z = cvt_pk_bf16(o[4], o[5]); w.w = cvt_pk_bf16(o[6], o[7]); *(u32x4*)(X + off) = w; } }
    }
};

struct OrderScores {
    const char* Q; const char* K; int G, c;
    __device__ __forceinline__ bool next(int i, Unit& u) const { const int L = i * G + c; if (L >= 256) return false; u.pm = L; u.pn = 0; u.nt = 4; u.ks = -1; u.a = Q + (size_t)L * 131072; u.b = K + (size_t)L * 131072; return true; }
};
struct OrderUT {
    const char* BC; const char* KT; int G, c;
    __device__ __forceinline__ bool next(int i, Unit& u) const { const int L = i * G + c; if (L >= 512) return false; u.pm = L & 255; u.pn = L >> 8;
        u.nt = 4; u.ks = -1; u.a = BC + ((size_t)u.pm * 512 + u.pn * 256) * 1024; u.b = KT + (size_t)u.pm * 131072; return true; }
};
struct OrderO {
    const char* AC; const char* BC; int G, c, v;
    __device__ __forceinline__ bool next(int i, Unit& u) const {
        int L;
        if (G == 256) {
            if (v < 128) { if (i > 0) return false; L = 128 + v; }
            else { if (i > 2) return false; const int li = v - 128; L = i == 0 ? li : (i == 1 ? li + 256 : 384 + li); } }
        else { L = i * G + c; if (L >= 512) return false; }
        u.pm = L & 255; u.pn = L >> 8;
        u.nt = 8; u.ks = -1; u.a = AC + (size_t)u.pm * 262144; u.b = BC + ((size_t)u.pm * 512 + u.pn * 256) * 1024; return true; }
};
struct OrderLru {
    const char* XC; const char* W; int G, c;
    __device__ __forceinline__ bool next(int i, Unit& u) const { const int L = i * G + c; if (L >= 576) return false; u.pm = L % 36; u.pn = L / 36;
        u.nt = 4; u.ks = -1; u.a = XC + ((size_t)u.pm * 256 * D + (u.pn >> 1) * 256) * 2; u.b = W + (size_t)u.pn * 131072; return true; }
};

#define XB_TMO      128
#define XB_XCNT(j)  (256  + 64 * (j))
#define XB_XSUB(j)  (1280 + 64 * (j))
#define XB_XGEN(j)  (2304 + 64 * (j))
#define XB_TOP      3328
#define XB_TOPGEN   3392
#define XCD_BAR_WORDS 3456
#define XB_SPIN_CAP (1u << 18)
__device__ __forceinline__ unsigned xb_ld(unsigned* p)              { return __hip_atomic_load(p, __ATOMIC_RELAXED, __HIP_MEMORY_SCOPE_AGENT); }
__device__ __forceinline__ unsigned xb_add(unsigned* p, unsigned v) { return __hip_atomic_fetch_add(p, v, __ATOMIC_RELAXED, __HIP_MEMORY_SCOPE_AGENT); }
__device__ __forceinline__ unsigned xb_xcc_id() { return (unsigned)__builtin_amdgcn_s_getreg((3 << 11) | 20) & 0xFu; }
#define XB_SPIN(cond, bar) do { unsigned _sp = 0; while (cond) { __builtin_amdgcn_s_sleep(1); \
    if ((++_sp & 255u) == 0u) { if (xb_ld(&(bar)[XB_TMO])) break; if (_sp > XB_SPIN_CAP) { atomicAdd(&(bar)[XB_TMO], 1u); break; } } } } while (0)
struct XcdBarrier { unsigned* bar; unsigned x; volatile LAS unsigned* st; };
__device__ __forceinline__ XcdBarrier xcd_barrier_post(unsigned* bar, volatile LAS unsigned* st) {
    XcdBarrier b; b.bar = bar; b.x = xb_xcc_id(); b.st = st;
    if (threadIdx.x == 0) (void)xb_add(&bar[XB_XCNT(b.x)], 1u);
    return b;
}
__device__ __forceinline__ void xcd_barrier_complete(unsigned* bar, unsigned x, unsigned& nloc, unsigned& nx) {
    const unsigned G = gridDim.x * gridDim.y * gridDim.z;
    unsigned sum, cnt, mine, sp = 0u;
    for (;;) {
        sum = 0u; cnt = 0u; mine = 0u;
#pragma unroll
        for (unsigned j = 0; j < 16; ++j) { const unsigned c = xb_ld(&bar[XB_XCNT(j)]); sum += c; cnt += (c > 0u) ? 1u : 0u; mine = (j == x) ? c : mine; }
        if (sum == G) break;
        __builtin_amdgcn_s_sleep(1);
        if ((++sp & 255u) == 0u) { if (xb_ld(&bar[XB_TMO])) break; if (sp > XB_SPIN_CAP) { atomicAdd(&bar[XB_TMO], 1u); break; } }
    }
    nloc = mine > 0u ? mine : 1u; nx = cnt > 0u ? cnt : 1u;
}
__device__ __forceinline__ void xcd_barrier(const XcdBarrier& b) {
    asm volatile("s_waitcnt vmcnt(0)" ::: "memory");
    __syncthreads();
    if (threadIdx.x == 0) {
        unsigned* bar = b.bar;
        __builtin_amdgcn_s_waitcnt(0);
        unsigned nloc = b.st[0], nx = b.st[1];
        if (nloc == 0u) { xcd_barrier_complete(bar, b.x, nloc, nx); b.st[0] = nloc; b.st[1] = nx; }
        const unsigned old = xb_add(&bar[XB_XSUB(b.x)], 1u);
        const unsigned gen = old / nloc;
        if (old + 1u == (gen + 1u) * nloc) {
            __builtin_amdgcn_fence(__ATOMIC_RELEASE, "agent");
            asm volatile("s_waitcnt vmcnt(0)" ::: "memory");
            const unsigned og = xb_add(&bar[XB_TOP], 1u);
            const unsigned tg = og / nx;
            if (og + 1u == (tg + 1u) * nx) xb_add(&bar[XB_TOPGEN], 1u);
            else XB_SPIN(xb_ld(&bar[XB_TOPGEN]) == tg, bar);
            __builtin_amdgcn_fence(__ATOMIC_ACQUIRE, "agent");
            xb_add(&bar[XB_XGEN(b.x)], 1u);
            asm volatile("s_waitcnt vmcnt(0)" ::: "memory");
        } else {
            XB_SPIN(xb_ld(&bar[XB_XGEN(b.x)]) == gen, bar);
            __builtin_amdgcn_fence(__ATOMIC_ACQUIRE, "agent");
            asm volatile("s_waitcnt vmcnt(0)" ::: "memory");
        }
    }
    __syncthreads();
}

struct TrItem { const float* W; bf16* WT; size_t drow0; int ldw, k0, n0, ldt; unsigned char* WT8; const unsigned* cm; };
__device__ __forceinline__ void tr_load(const TrItem& t, f32x4 (&v)[8], int lane) {
#pragma unroll
    for (int i = 0; i < 8; ++i) { const int kk = (lane >> 3) + 8 * i, c4 = lane & 7; v[i] = *(const f32x4*)(t.W + (size_t)(t.k0 + kk) * t.ldw + t.n0 + 4 * c4); }
}
__device__ __forceinline__ void tr_finish(const TrItem& t, const f32x4 (&v)[8], LAS float* scr, int lane) {
#pragma unroll
    for (int i = 0; i < 8; ++i) { const int kk = (lane >> 3) + 8 * i, c4 = lane & 7; LAS float* s = scr + kk * 33 + 4 * c4; s[0] = v[i][0]; s[1] = v[i][1]; s[2] = v[i][2]; s[3] = v[i][3]; }
    LDS_WAIT(); asm volatile("" ::: "memory");
    const int c = lane & 7;
#pragma unroll
    for (int j = 0; j < 4; ++j) { const int n = (lane >> 3) + 8 * j; const LAS float* s = scr + (8 * c) * 33 + n;
        if (t.WT8 && t.cm) { const float cmx = __uint_as_float(t.cm[t.drow0 + n]), qs = cmx > 0.f ? 127.0f / cmx : 0.f; u32x2 o8;
            o8.x = f2i8x4(s[0 * 33] * qs, s[1 * 33] * qs, s[2 * 33] * qs, s[3 * 33] * qs); o8.y = f2i8x4(s[4 * 33] * qs, s[5 * 33] * qs, s[6 * 33] * qs, s[7 * 33] * qs);
            *(u32x2*)(t.WT8 + (t.drow0 + n) * (size_t)t.ldt + t.k0 + 8 * c) = o8; }
        else if (t.WT8) { u32x2 o8; o8.x = f2fp8x4(s[0 * 33] * W8_SCALE, s[1 * 33] * W8_SCALE, s[2 * 33] * W8_SCALE, s[3 * 33] * W8_SCALE); o8.y = f2fp8x4(s[4 * 33] * W8_SCALE, s[5 * 33] * W8_SCALE, s[6 * 33] * W8_SCALE, s[7 * 33] * W8_SCALE);
            *(u32x2*)(t.WT8 + (t.drow0 + n) * (size_t)t.ldt + t.k0 + 8 * c) = o8; }
        else { u32x4 o; o.x = cvt_pk_bf16(s[0 * 33], s[1 * 33]); o.y = cvt_pk_bf16(s[2 * 33], s[3 * 33]); o.z = cvt_pk_bf16(s[4 * 33], s[5 * 33]); o.w = cvt_pk_bf16(s[6 * 33], s[7 * 33]);
            *(u32x4*)(t.WT + (t.drow0 + n) * (size_t)t.ldt + t.k0 + 8 * c) = o; } }
    LDS_WAIT(); asm volatile("" ::: "memory");
}
template <bool BF> __device__ __forceinline__ f32x4 ldrow4(const void* row, int i) { if (BF) { const u32x2 w = ((const u32x2*)row)[i]; return (f32x4){bflo(w.x), bfhi(w.x), bflo(w.y), bfhi(w.y)}; } else return ((const f32x4*)row)[i]; }
__device__ __forceinline__ void tr_absmax(const TrItem& t, const f32x4 (&v)[8], unsigned* cm, int lane) {
    f32x4 mx = {0.f, 0.f, 0.f, 0.f};
#pragma unroll
    for (int i = 0; i < 8; ++i)
#pragma unroll
        for (int e = 0; e < 4; ++e) mx[e] = fmaxf(mx[e], fabsf(v[i][e]));
#pragma unroll
    for (int e = 0; e < 4; ++e) { float m = mx[e]; m = fmaxf(m, __shfl_xor(m, 8)); m = fmaxf(m, __shfl_xor(m, 16)); m = fmaxf(m, __shfl_xor(m, 32)); mx[e] = m; }
    if (lane < 8) {
#pragma unroll
        for (int e = 0; e < 4; ++e) atomicMax(cm + t.drow0 + 4 * lane + e, __float_as_uint(mx[e])); }
}
template <bool INBF> __device__ __forceinline__ void rms_row_q8(const void* xrow, const float* gain, unsigned char* qrow, float* rs, int lane, bf16* orow = nullptr) {
    f32x4 v[8]; float s = 0.f;
#pragma unroll
    for (int j = 0; j < 8; ++j) { v[j] = ldrow4<INBF>(xrow, lane + 64 * j); s += (v[j][0] * v[j][0] + v[j][1] * v[j][1]) + (v[j][2] * v[j][2] + v[j][3] * v[j][3]); }
    const float rstd = 1.0f / sqrtf(wave_sum(s) * (1.0f / D) + EPS);
    float mx = 0.f;
#pragma unroll
    for (int j = 0; j < 8; ++j) { const f32x4 g = ((const f32x4*)gain)[lane + 64 * j]; v[j] = v[j] * rstd * g; mx = fmaxf(fmaxf(mx, fmaxf(fabsf(v[j][0]), fabsf(v[j][1]))), fmaxf(fabsf(v[j][2]), fabsf(v[j][3]))); }
    mx = wave_max(mx); const float qs = mx > 0.f ? 127.0f / mx : 0.f;
#pragma unroll
    for (int j = 0; j < 8; ++j) { ((unsigned*)qrow)[lane + 64 * j] = f2i8x4(v[j][0] * qs, v[j][1] * qs, v[j][2] * qs, v[j][3] * qs);
        if (orow) ((u32x2*)orow)[lane + 64 * j] = (u32x2){pk2(v[j][0], v[j][1]), pk2(v[j][2], v[j][3])}; }
    if (lane == 0) *rs = mx * (1.0f / 127.0f);
}
template <bool INBF> __device__ __forceinline__ void rms_row_bf16(const void* xrow, const float* gain, bf16* orow, int lane, unsigned char* o8row = nullptr) {
    f32x4 v[8]; float s = 0.f;
#pragma unroll
    for (int j = 0; j < 8; ++j) { v[j] = ldrow4<INBF>(xrow, lane + 64 * j); s += (v[j][0] * v[j][0] + v[j][1] * v[j][1]) + (v[j][2] * v[j][2] + v[j][3] * v[j][3]); }
    const float rstd = 1.0f / sqrtf(wave_sum(s) * (1.0f / D) + EPS);
    unsigned long long* o8 = (unsigned long long*)orow + lane;
#pragma unroll
    for (int j = 0; j < 8; ++j) { const f32x4 g = ((const f32x4*)gain)[lane + 64 * j];
        o8[64 * j] = (unsigned long long)pk2(v[j][0] * rstd * g[0], v[j][1] * rstd * g[1]) | ((unsigned long long)pk2(v[j][2] * rstd * g[2], v[j][3] * rstd * g[3]) << 32);
        if (o8row) ((unsigned*)o8row)[lane + 64 * j] = f2fp8x4(v[j][0] * rstd * g[0], v[j][1] * rstd * g[1], v[j][2] * rstd * g[2], v[j][3] * rstd * g[3]); }
}
template <bool INBF> __device__ __forceinline__ void rms_row_slab_bf16(const void* base, const float* slabrow, float alpha, bf16* xout, const float* gain, bf16* orow, int lane, unsigned char* o8row = nullptr) {
    f32x4 v[8]; float s = 0.f;
#pragma unroll
    for (int j = 0; j < 8; ++j) { f32x4 a = {0.f, 0.f, 0.f, 0.f};
#pragma unroll
        for (int k = 0; k < 8; ++k) { const u32x2 w = ((const u32x2*)((const bf16*)slabrow + (size_t)k * MS * D))[lane + 64 * j]; a += (f32x4){bflo(w.x), bfhi(w.x), bflo(w.y), bfhi(w.y)}; }
        v[j] = ldrow4<INBF>(base, lane + 64 * j) + alpha * a; ((u32x2*)xout)[lane + 64 * j] = (u32x2){cvt_pk_bf16(v[j][0], v[j][1]), cvt_pk_bf16(v[j][2], v[j][3])};
        s += (v[j][0] * v[j][0] + v[j][1] * v[j][1]) + (v[j][2] * v[j][2] + v[j][3] * v[j][3]); }
    const float rstd = 1.0f / sqrtf(wave_sum(s) * (1.0f / D) + EPS);
    unsigned long long* o8 = (unsigned long long*)orow + lane;
#pragma unroll
    for (int j = 0; j < 8; ++j) { const f32x4 g = ((const f32x4*)gain)[lane + 64 * j];
        o8[64 * j] = (unsigned long long)pk2(v[j][0] * rstd * g[0], v[j][1] * rstd * g[1]) | ((unsigned long long)pk2(v[j][2] * rstd * g[2], v[j][3] * rstd * g[3]) << 32);
        if (o8row) ((unsigned*)o8row)[lane + 64 * j] = f2fp8x4(v[j][0] * rstd * g[0], v[j][1] * rstd * g[1], v[j][2] * rstd * g[2], v[j][3] * rstd * g[3]); }
}
template <bool INBF> __device__ __forceinline__ void rms_row_slab_q8(const void* base, const float* slabrow, float alpha, bf16* xout, const float* gain, unsigned char* qrow, float* rs, int lane, bf16* orow = nullptr) {
    f32x4 v[8]; float s = 0.f;
#pragma unroll
    for (int j = 0; j < 8; ++j) { f32x4 a = {0.f, 0.f, 0.f, 0.f};
#pragma unroll
        for (int k = 0; k < 8; ++k) { const u32x2 w = ((const u32x2*)((const bf16*)slabrow + (size_t)k * MS * D))[lane + 64 * j]; a += (f32x4){bflo(w.x), bfhi(w.x), bflo(w.y), bfhi(w.y)}; }
        v[j] = ldrow4<INBF>(base, lane + 64 * j) + alpha * a; ((u32x2*)xout)[lane + 64 * j] = (u32x2){cvt_pk_bf16(v[j][0], v[j][1]), cvt_pk_bf16(v[j][2], v[j][3])};
        s += (v[j][0] * v[j][0] + v[j][1] * v[j][1]) + (v[j][2] * v[j][2] + v[j][3] * v[j][3]); }
    const float rstd = 1.0f / sqrtf(wave_sum(s) * (1.0f / D) + EPS);
    float mx = 0.f;
#pragma unroll
    for (int j = 0; j < 8; ++j) { const f32x4 g = ((const f32x4*)gain)[lane + 64 * j]; v[j] = v[j] * rstd * g; mx = fmaxf(fmaxf(mx, fmaxf(fabsf(v[j][0]), fabsf(v[j][1]))), fmaxf(fabsf(v[j][2]), fabsf(v[j][3]))); }
    mx = wave_max(mx); const float qs = mx > 0.f ? 127.0f / mx : 0.f;
#pragma unroll
    for (int j = 0; j < 8; ++j) { ((unsigned*)qrow)[lane + 64 * j] = f2i8x4(v[j][0] * qs, v[j][1] * qs, v[j][2] * qs, v[j][3] * qs);
        if (orow) ((u32x2*)orow)[lane + 64 * j] = (u32x2){pk2(v[j][0], v[j][1]), pk2(v[j][2], v[j][3])}; }
    if (lane == 0) *rs = mx * (1.0f / 127.0f);
}
__device__ __forceinline__ void rms_row_f32(const bf16* xrow, const float* gain, float* orow, int lane) {
    f32x4 v[8]; float s = 0.f;
#pragma unroll
    for (int j = 0; j < 8; ++j) { v[j] = ldrow4<true>(xrow, lane + 64 * j); s += (v[j][0] * v[j][0] + v[j][1] * v[j][1]) + (v[j][2] * v[j][2] + v[j][3] * v[j][3]); }
    const float rstd = 1.0f / sqrtf(wave_sum(s) * (1.0f / D) + EPS);
#pragma unroll
    for (int j = 0; j < 8; ++j) { const f32x4 g = ((const f32x4*)gain)[lane + 64 * j]; ((f32x4*)orow)[lane + 64 * j] = v[j] * rstd * g; }
}

__device__ __forceinline__ void rms_row_ple_f32(const bf16* xrow, const float* slabrow, const float* bg, const bf16* trow, const float* gain, float* orow, int lane) {
    f32x4 v[8]; float s = 0.f;
#pragma unroll
    for (int j = 0; j < 8; ++j) { f32x4 a = ((const f32x4*)bg)[lane + 64 * j];
#pragma unroll
        for (int k = 0; k < 8; ++k) { const u32x2 w = ((const u32x2*)((const bf16*)slabrow + (size_t)k * MS * D))[lane + 64 * j]; a += (f32x4){bflo(w.x), bfhi(w.x), bflo(w.y), bfhi(w.y)}; }
        const u32x2 tw = ((const u32x2*)trow)[lane + 64 * j]; const f32x4 t = {bflo(tw.x), bfhi(tw.x), bflo(tw.y), bfhi(tw.y)}, x = ldrow4<true>(xrow, lane + 64 * j);
#pragma unroll
        for (int e = 0; e < 4; ++e) v[j][e] = x[e] + sigmoidf_(a[e]) * t[e];
        s += (v[j][0] * v[j][0] + v[j][1] * v[j][1]) + (v[j][2] * v[j][2] + v[j][3] * v[j][3]); }
    const float rstd = 1.0f / sqrtf(wave_sum(s) * (1.0f / D) + EPS);
#pragma unroll
    for (int j = 0; j < 8; ++j) { const f32x4 g = ((const f32x4*)gain)[lane + 64 * j]; ((f32x4*)orow)[lane + 64 * j] = v[j] * rstd * g; }
}

struct Args { const float* in[34]; float* out; unsigned char* ws; int ph_lo, ph_hi; };
constexpr int NPHASE = 17;

__global__ void __launch_bounds__(NWAVES * 64, 2) mega_fwd(Args args) {
    extern __shared__ __attribute__((aligned(16))) unsigned char lds_raw[];
    LAS unsigned char* lds = (LAS unsigned char*)lds_raw;
    volatile LAS unsigned* MISC = (volatile LAS unsigned*)(lds + MISC_OFF);
    const int tid = threadIdx.x, lane = tid & 63, wave = __builtin_amdgcn_readfirstlane(tid >> 6);
    const int G = gridDim.x, bx = blockIdx.x;
    const int vcu = (G % 8 == 0) ? (bx % 8) * (G / 8) + bx / 8 : bx;
    const int gw = vcu * NWAVES + wave, NGW = G * NWAVES;
    const bool rb_ = (G == 256), ra_ = wave < 4; const int ria_ = vcu * 4 + (wave & 3);
    const int rnk_ = rb_ ? (ra_ ? 3 : 6) : (M + NGW - 1 - gw) / NGW;
#define ROWMAP(k) (rb_ ? (ra_ ? ((k) == 0 ? MP + ria_ : 2 * ria_ + (k) - 1) : 2048 + ria_ * 6 + (k)) : gw + (k) * NGW)
    const int gt = vcu * (NWAVES * 64) + tid, NGT = G * NWAVES * 64;
    unsigned char* ws = args.ws;
    gu32* ctl = (gu32*)(ws + WS_CTL);
    for (int w = tid; w < (LDS_BYTES - LDSCTL_OFF) / 4; w += NWAVES * 64) ((LAS unsigned*)(lds + LDSCTL_OFF))[w] = 0u;
    __syncthreads();
    XcdBarrier bar = xcd_barrier_post((unsigned*)(ctl + CW_BAR), MISC + 8);
    const int lo = args.ph_lo, hi = args.ph_hi;
#define IN(k) (lo <= (k) && (k) < hi)
#define SEAM(k) do { if (IN(k) && IN((k) + 1)) xcd_barrier(bar); } while (0)

#define x_prompt (args.in[0])
#define x_sample (args.in[1])
#define p_prompt (args.in[2])
#define p_sample (args.in[3])
#define state_lru (args.in[4])
#define state_conv (args.in[5])
#define state_ret (args.in[6])
#define ffn1_norm (args.in[7])
#define mix_norm (args.in[11])
#define b_in (args.in[13])
#define conv_w (args.in[14])
#define conv_b (args.in[15])
#define lru_ba (args.in[17])
#define lru_bx (args.in[19])
#define lru_lambda (args.in[20])
#define ret_norm (args.in[21])
#define ffn2_norm (args.in[25])
#define ple_norm (args.in[29])
#define ple_bg (args.in[31])
#define final_norm (args.in[33])
#define out (args.out)
#define W1A ((bf16*)(ws + WS_W1A))
#define W1D ((bf16*)(ws + WS_W1D))
#define W2A ((bf16*)(ws + WS_W2A))
#define W2D ((bf16*)(ws + WS_W2D))
#define WIN ((bf16*)(ws + WS_WIN))
#define WPA ((bf16*)(ws + WS_WPA))
#define WPB ((bf16*)(ws + WS_WPB))
#define WOUT ((bf16*)(ws + WS_WOUT))
#define WPG ((bf16*)(ws + WS_WPG))
#define WPP ((bf16*)(ws + WS_WPP))
#define WLRU ((bf16*)(ws + WS_WLRU))
#define COS ((float*)(ws + WS_COS))
#define SIN ((float*)(ws + WS_SIN))
#define U ((bf16*)(ws + WS_U))
#define HB ((bf16*)(ws + WS_HB))
#define X ((bf16*)(ws + WS_X))
#define XA ((bf16*)(ws + WS_XA))
#define SLAB ((float*)(ws + WS_XA))
#define GA ((bf16*)(ws + WS_GA))
#define Qb ((bf16*)(ws + WS_Q))
#define Kb ((bf16*)(ws + WS_K))
#define ACAT ((bf16*)(ws + WS_ACAT))
#define BCAT ((bf16*)(ws + WS_BCAT))
#define KTD ((bf16*)(ws + WS_KTD))
#define VTS ((bf16*)(ws + WS_VTS))
#define SG ((bf16*)(ws + WS_SG))
#define SA ((bf16*)(ws + WS_SA))
#define SB ((bf16*)(ws + WS_SB))
#define XC ((bf16*)(ws + WS_XC))
#define AA ((bf16*)(ws + WS_AA))
#define BB ((bf16*)(ws + WS_BB))
#define HL ((bf16*)(ws + WS_HL))
#define PC ((bf16*)(ws + WS_PC))
#define AGA ((float*)(ws + WS_AGA))
#define AGB ((float*)(ws + WS_AGB))
#define OA ((bf16*)(ws + WS_OA))
#define UT ((float*)(ws + WS_UT))
#define OF ((bf16*)(ws + WS_OF))
#define OB ((bf16*)(ws + WS_OB))
#define TMP ((float*)(ws + WS_TMP))
#define TMP2 ((float*)(ws + WS_TMP2))
#define MG ((bf16*)(ws + WS_MG))
#define PEB ((bf16*)(ws + WS_PE))
#define U8 ((unsigned char*)(ws + WS_U8))
#define WIN8 ((unsigned char*)(ws + WS_WIN8))
#define RS ((float*)(ws + WS_RS))
    LAS float* scr = (LAS float*)(lds + wave * 16384);
    constexpr int I_FA = 32 * 176, I_FD = 88 * 64, I_IN = 32 * 640, I_PA = 32 * 64, I_PB = 64 * 64, I_PP = 4 * 64, I_L = 4 * 8;
    constexpr int NITEMS = 6 * I_FA + I_IN + 3 * I_PA + I_PB + I_PP + 16 * I_L;
    static_assert(I_FA == I_FD, "ffn item counts");
    auto item = [&](int it) -> TrItem { TrItem t; t.WT8 = nullptr; t.cm = nullptr; int r = it;
        if (r < 6 * I_FA) { const int w = r / I_FA; r -= w * I_FA; const int f = w / 3, k = w % 3; t.W = args.in[(f ? 26 : 8) + k];
            if (k < 2) { const int kb = r / 176, nb = r % 176, n0 = nb * 32; t.ldw = FF; t.k0 = kb * 64; t.n0 = n0; t.WT = f ? W2A : W1A; t.drow0 = (size_t)(n0 >> 7) * 256 + k * 128 + (n0 & 127); t.ldt = D; t.WT8 = (unsigned char*)(f ? W2A : W1A); t.cm = (const unsigned*)(ctl + (f ? CW_CM2 : CW_CM1)); }
            else { const int kb = r / 64, nb = r % 64; t.ldw = D; t.k0 = kb * 64; t.n0 = nb * 32; t.WT = f ? W2D : W1D; t.drow0 = (size_t)nb * 32; t.ldt = FF; t.WT8 = (unsigned char*)(f ? W2D : W1D); }
            return t; }
        r -= 6 * I_FA;
        if (r < I_IN) { const int kb = r / 640, nb = r % 640; t.W = args.in[12]; t.ldw = NIN; t.k0 = kb * 64; t.n0 = nb * 32; t.WT = WIN; t.drow0 = (size_t)nb * 32; t.ldt = D; { const int ct = nb >> 3; if ((ct >= 8 && ct < 24) || ct >= 48) { t.WT8 = WIN8; t.cm = (const unsigned*)(ctl + CW_CM3); } } return t; } r -= I_IN;
        if (r < I_PA) { const int kb = r / 64, nb = r % 64; t.W = args.in[22]; t.ldw = D; t.k0 = kb * 64; t.n0 = nb * 32; t.WT = WPA; t.drow0 = (size_t)nb * 32; t.ldt = D; return t; } r -= I_PA;
        if (r < I_PB) { const int kb = r / 64, nb = r % 64; t.W = args.in[23]; t.ldw = D; t.k0 = kb * 64; t.n0 = nb * 32; t.WT = WPB; t.drow0 = (size_t)nb * 32; t.ldt = VD; t.WT8 = (unsigned char*)WPB; return t; } r -= I_PB;
        if (r < I_PA) { const int kb = r / 64, nb = r % 64; t.W = args.in[24]; t.ldw = D; t.k0 = kb * 64; t.n0 = nb * 32; t.WT = WOUT; t.drow0 = (size_t)nb * 32; t.ldt = D; return t; } r -= I_PA;
        if (r < I_PA) { const int kb = r / 64, nb = r % 64; t.W = args.in[30]; t.ldw = D; t.k0 = kb * 64; t.n0 = nb * 32; t.WT = WPG; t.drow0 = (size_t)nb * 32; t.ldt = D; t.WT8 = (unsigned char*)WPG; t.cm = (const unsigned*)(ctl + CW_CM4); return t; } r -= I_PA;
        if (r < I_PP) { const int kb = r / 64, nb = r % 64; t.W = args.in[32]; t.ldw = D; t.k0 = kb * 64; t.n0 = nb * 32; t.WT = WPP; t.drow0 = (size_t)nb * 32; t.ldt = PLE; return t; } r -= I_PP;
        { const int mat = r / I_L, q = r % I_L, which = mat >> 3, blk = mat & 7, kb = q / 8, nb = q % 8, n0 = nb * 32;
          t.W = args.in[which ? 18 : 16] + (size_t)blk * 65536; t.ldw = 256; t.k0 = kb * 64; t.n0 = n0; t.WT = WLRU; t.drow0 = (size_t)(2 * blk + (n0 >> 7)) * 256 + which * 128 + (n0 & 127); t.ldt = 256; return t; } };
    constexpr int R_W1A0 = 0, R_W1D0 = 2 * I_FA, R_W2A0 = 3 * I_FA, R_W2D0 = 5 * I_FA, R_WIN0 = 6 * I_FA, R_PA0 = R_WIN0 + I_IN, R_PB0 = R_PA0 + I_PA, R_WOUT0 = R_PB0 + I_PB, R_WPG0 = R_WOUT0 + I_PA, R_WPP0 = R_WPG0 + I_PA, R_LRU0 = R_WPP0 + I_PP;
    static_assert(R_LRU0 + 16 * I_L == NITEMS, "item ranges");
    auto convert = [&](int lo, int hi, int wk, int nwk) {
        f32x4 va[8], vb[8]; int it = lo + wk; TrItem ta, tb;
        if (it < hi) { ta = item(it); tr_load(ta, va, lane); }
        while (it < hi) {
            const int itb = it + nwk, itc = it + 2 * nwk;
            if (itb < hi) { tb = item(itb); tr_load(tb, vb, lane); }
            tr_finish(ta, va, scr, lane);
            if (itc < hi) { ta = item(itc); tr_load(ta, va, lane); }
            if (itb < hi) tr_finish(tb, vb, scr, lane);
            it = itc; } };
    auto absmax = [&](int lo, int hi, int wk, int nwk, unsigned* cm) {
        f32x4 va[8], vb[8]; int it = lo + wk; TrItem ta, tb;
        bool ha = false, hb = false;
        if (it < hi) { ta = item(it); ha = ta.cm != nullptr; if (ha) tr_load(ta, va, lane); }
        while (it < hi) {
            const int itb = it + nwk, itc = it + 2 * nwk;
            hb = false; if (itb < hi) { tb = item(itb); hb = tb.cm != nullptr; if (hb) tr_load(tb, vb, lane); }
            if (ha) tr_absmax(ta, va, cm, lane);
            ha = false; if (itc < hi) { ta = item(itc); ha = ta.cm != nullptr; if (ha) tr_load(ta, va, lane); }
            if (hb) tr_absmax(tb, vb, cm, lane);
            it = itc; } };
    if (IN(0)) {
        absmax(R_W1A0, R_W1D0, gw, NGW, (unsigned*)(ctl + CW_CM1));
        convert(R_W1D0, R_W1D0 + I_FA, gw, NGW);
        absmax(R_WIN0, R_WIN0 + I_IN, gw, NGW, (unsigned*)(ctl + CW_CM3));
        for (int i = gt; i < 2056 * 128; i += NGT) { const int tp = i >> 7, f = i & 127; const int pos = tp < 2048 ? tp : 16384 + (tp - 2048);
            const float inv = exp2f(-(float)f * (13.287712379549449f / 128.0f)); const float ang = (float)pos * inv; COS[i] = cosf(ang); SIN[i] = sinf(ang); }
        for (int i = gt; i < M * PLE / 4; i += NGT) { const int row = i >> 6, c4 = i & 63;
            const f32x4 v = (row < MP) ? ((const f32x4*)p_prompt)[(size_t)row * 64 + c4] : ((const f32x4*)p_sample)[(size_t)(row - MP) * 64 + c4];
            ((u32x2*)PEB)[i] = (u32x2){pk2(v[0], v[1]), pk2(v[2], v[3])}; }
        for (int m = gw; m < M; m += NGW) rms_row_q8<false>(m < MP ? x_prompt + (size_t)m * D : x_sample + (size_t)(m - MP) * D, ffn1_norm, U8 + (size_t)m * D, RS + m, lane);
        __syncthreads();
        xcd_barrier(bar);
        convert(R_W1A0, R_W1D0, gw, NGW);
        __syncthreads();
    }
    SEAM(0);
    if (IN(1)) { pg8::TileOrder S; S.init(U8, (size_t)256 * D, W1A, (size_t)256 * D, 36, 44, D / 128, G, bx); EpiSwigluQ8 E{(unsigned char*)HB, RS, (const unsigned*)(ctl + CW_CM1)};
        pg8::gemm_phase<EpiSwigluQ8, pg8::TileOrder, 2>(lds, D / 2, D / 2, S, E);
        if (bx >= 1584 - 6 * 256) convert(R_WIN0, R_WIN0 + I_IN, (bx - (1584 - 6 * 256)) * NWAVES + wave, (G - (1584 - 6 * 256)) * NWAVES); }
    SEAM(1);
    if (IN(2)) { pg8::SplitOrder S; S.init(HB, (size_t)256 * FF, W1D, (size_t)256 * FF, FF / 128, G, bx); EpiResid<false> E{x_prompt, X, 0.5f / (H8_SCALE * W8_SCALE), SLAB, 1.0f / (H8_SCALE * W8_SCALE)};
        pg8::gemm_phase<EpiResid<false>, pg8::SplitOrder, 1>(lds, FF / 2, FF / 2, S, E); }
    SEAM(2);
    if (IN(3)) { for (int k_ = 0; k_ < rnk_; ++k_) { const int m = ROWMAP(k_); if (m < MP) rms_row_q8<true>(X + (size_t)m * D, mix_norm, U8 + (size_t)m * D, RS + m, lane, U + (size_t)m * D);
            else rms_row_slab_q8<false>(x_sample + (size_t)(m - MP) * D, (const float*)((const bf16*)SLAB + (size_t)(m - MP) * D), 0.5f, X + (size_t)m * D, mix_norm, U8 + (size_t)m * D, RS + m, lane, U + (size_t)m * D); } }
    SEAM(3);
    if (IN(4)) {
        { pg8::TileOrder S; S.init(U8, (size_t)256 * D, WIN8, (size_t)256 * D, 36, 48, D / 128, G, bx); S.pn_s1 = 16; S.pn_a = 8; S.pn_b = 48;
          EpiMix<true> E{b_in, COS, SIN, XA, GA, Qb, Kb, ACAT, BCAT, KTD, VTS, SG, SA, SB, lds + XPOSE_OFF, RS, (const unsigned*)(ctl + CW_CM3)};
          pg8::gemm_phase<EpiMix<true>, pg8::TileOrder, 2>(lds, D / 2, D / 2, S, E); }
        { pg8::TileOrder S; S.init(U, (size_t)256 * D * 2, WIN, (size_t)256 * D * 2, 36, 32, D / 64, G, (bx + G - 1728 % G) % G); S.pn_s1 = 8; S.pn_s2 = 16; S.pn_a = 0; S.pn_b = 24; S.pn_c = 32;
          EpiMix<false> E{b_in, COS, SIN, XA, GA, Qb, Kb, ACAT, BCAT, KTD, VTS, SG, SA, SB, lds + XPOSE_OFF, RS, (const unsigned*)(ctl + CW_CM3)};
          pg8::gemm_phase<EpiMix<false>, pg8::TileOrder, 0>(lds, D, D, S, E); }
        { const int c2 = (bx + G - 1728 % G) % G, nlast = G / 2;
          if (c2 >= nlast) { const int wk = (c2 - nlast) * NWAVES + wave, nwk = (G - nlast) * NWAVES;
            convert(R_LRU0, NITEMS, wk, nwk); convert(R_PA0, R_WPG0, wk, nwk); absmax(R_W2A0, R_W2D0, wk, nwk, (unsigned*)(ctl + CW_CM2)); absmax(R_WPG0, R_WPP0, wk, nwk, (unsigned*)(ctl + CW_CM4)); } }
    }
    SEAM(4);
    if (IN(5)) {
        if (bx & 1) {
        {
            LAS float* tab = (LAS float*)lds;
            LAS float* red = (LAS float*)(lds + 16384);
            LAS float* scs = (LAS float*)(lds + 16384 + 65536);
            for (int un = vcu; un < NBS * NH; un += G) {
                const int b = un >> 3, hh = un & 7; const float l2g = log2gamma(hh);
                const bf16* q = Qb + (size_t)32 * 2048 * 256 + (size_t)un * 2048; const bf16* k = Kb + (size_t)32 * 2048 * 256 + (size_t)un * 2048; const bf16* vt = VTS + (size_t)un * 4096;
                const float* S0 = state_ret + (size_t)un * 131072; float* Sn = out + O_RETS + (size_t)un * 131072;
                { const int dk = tid >> 1, which = tid & 1; const bf16* src = which ? k : q;
#pragma unroll
                  for (int i = 0; i < 8; ++i) tab[dk * 16 + which * 8 + i] = bf1(src[i * 256 + dk]) * fast_exp2((float)(which ? 7 - i : i + 1) * l2g); }
                { const int i = wave;
                  const u32x2 qw = ((const u32x2*)(q + i * 256))[lane]; const float q0 = bflo(qw.x), q1 = bfhi(qw.x), q2 = bflo(qw.y), q3 = bfhi(qw.y);
                  for (int j = 0; j < 8; ++j) { const u32x2 kw = ((const u32x2*)(k + j * 256))[lane];
                      float d = q0 * bflo(kw.x) + q1 * bfhi(kw.x) + q2 * bflo(kw.y) + q3 * bfhi(kw.y); d = wave_sum(d);
                      if (lane == 0) scs[i * 8 + j] = (j <= i) ? d * fast_exp2((float)(i - j) * l2g) : 0.0f; } }
                __syncthreads();
                const int dkq = tid >> 7, dv4 = tid & 127;
                float vv[4][8];
#pragma unroll
                for (int e = 0; e < 4; ++e) { const u32x4 w = *(const u32x4*)(vt + (size_t)(4 * dv4 + e) * 8);
                    vv[e][0] = bflo(w.x); vv[e][1] = bfhi(w.x); vv[e][2] = bflo(w.y); vv[e][3] = bfhi(w.y); vv[e][4] = bflo(w.z); vv[e][5] = bfhi(w.z); vv[e][6] = bflo(w.w); vv[e][7] = bfhi(w.w); }
                f32x4 cross[8];
#pragma unroll
                for (int i = 0; i < 8; ++i) cross[i] = (f32x4){0.f, 0.f, 0.f, 0.f};
                const float g8 = fast_exp2(8.0f * l2g);
                for (int it0 = 0; it0 < 64; it0 += 16) {
                    f32x4 sv[16];
#pragma unroll
                    for (int q2 = 0; q2 < 16; ++q2) sv[q2] = __builtin_nontemporal_load((const f32x4*)(S0 + (size_t)(4 * (it0 + q2) + dkq) * 512) + dv4);
#pragma unroll
                    for (int q2 = 0; q2 < 16; ++q2) { const int dk = 4 * (it0 + q2) + dkq; const f32x4 s = sv[q2];
                        const LAS f32x4* tq = (const LAS f32x4*)(tab + dk * 16); const f32x4 qa = tq[0], qb = tq[1], ka = tq[2], kb = tq[3];
                        cross[0] += qa[0] * s; cross[1] += qa[1] * s; cross[2] += qa[2] * s; cross[3] += qa[3] * s; cross[4] += qb[0] * s; cross[5] += qb[1] * s; cross[6] += qb[2] * s; cross[7] += qb[3] * s;
                        f32x4 sn = g8 * s;
#pragma unroll
                        for (int e = 0; e < 4; ++e) sn[e] += ka[0] * vv[e][0] + ka[1] * vv[e][1] + ka[2] * vv[e][2] + ka[3] * vv[e][3] + kb[0] * vv[e][4] + kb[1] * vv[e][5] + kb[2] * vv[e][6] + kb[3] * vv[e][7];
                        __builtin_nontemporal_store(sn, (f32x4*)(Sn + (size_t)dk * 512) + dv4); } }
#pragma unroll
                for (int i = 0; i < 8; ++i) *(LAS f32x4*)(red + ((dkq * 8 + i) * 512 + 4 * dv4)) = cross[i];
                __syncthreads();
                { const int dv = tid; const u32x4 w = *(const u32x4*)(vt + (size_t)dv * 8);
                  const float v[8] = {bflo(w.x), bfhi(w.x), bflo(w.y), bfhi(w.y), bflo(w.z), bfhi(w.z), bflo(w.w), bfhi(w.w)};
                  float o[8];
#pragma unroll
                  for (int i = 0; i < 8; ++i) { float a = (red[(0 * 8 + i) * 512 + dv] + red[(1 * 8 + i) * 512 + dv]) + (red[(2 * 8 + i) * 512 + dv] + red[(3 * 8 + i) * 512 + dv]);
#pragma unroll
                      for (int j = 0; j < 8; ++j) a += scs[i * 8 + j] * v[j];
                      o[i] = a; const float ss = wave_sum(a * a); if (lane == 0) scs[64 + wave * 8 + i] = ss; }
                  __syncthreads();
                  const float gn = ret_norm[hh * 512 + dv];
#pragma unroll
                  for (int i = 0; i < 8; ++i) { float tot = 0.f;
#pragma unroll
                      for (int w8 = 0; w8 < 8; ++w8) tot += scs[64 + w8 * 8 + i];
                      const float rstd = 1.0f / sqrtf(tot * (1.0f / 512.0f) + EPS); const size_t off = (size_t)(MP + b * 8 + i) * VD + hh * 512 + dv;
                      ((unsigned char*)OB)[off] = (unsigned char)(f2fp8x4(__builtin_amdgcn_fmed3f(o[i] * rstd * gn * bf1(SG[off]) * O8_SCALE, -440.0f, 440.0f), 0.f, 0.f, 0.f) & 255u); } }
                __syncthreads();
            }
        }
        for (int it = gt; it < (M / 8) * 512; it += NGT) { const int rc = it >> 9, c4 = it & 511, r0 = rc * 8;
            const f32x4 w0 = ((const f32x4*)conv_w)[c4], w1 = ((const f32x4*)conv_w)[512 + c4], w2 = ((const f32x4*)conv_w)[1024 + c4], w3 = ((const f32x4*)conv_w)[1536 + c4], cb = ((const f32x4*)conv_b)[c4];
            const u32x2* xa4 = (const u32x2*)XA + c4; f32x4 p0, p1, p2; const f32x4 z = {0.f, 0.f, 0.f, 0.f};
#define XA_ROW(r) ({ const u32x2 w_ = xa4[(size_t)(r) * 512]; (f32x4){bflo(w_.x), bfhi(w_.x), bflo(w_.y), bfhi(w_.y)}; })
            if (r0 < MP) { if ((r0 & (TP - 1)) == 0) { p0 = z; p1 = z; p2 = z; } else { p0 = XA_ROW(r0 - 3); p1 = XA_ROW(r0 - 2); p2 = XA_ROW(r0 - 1); } }
            else { const int b = (r0 - MP) >> 3; const f32x4* sc = (const f32x4*)state_conv + (size_t)b * 3 * 512 + c4; p0 = sc[0]; p1 = sc[512]; p2 = sc[1024]; }
            f32x4 cur[8];
#pragma unroll
            for (int t = 0; t < 8; ++t) cur[t] = XA_ROW(r0 + t);
#undef XA_ROW
#pragma unroll
            for (int t = 0; t < 8; ++t) { const f32x4 y = cb + w0 * p0 + w1 * p1 + w2 * p2 + w3 * cur[t];
                ((u32x2*)XC)[(size_t)(r0 + t) * 512 + c4] = (u32x2){pk2(y[0], y[1]), pk2(y[2], y[3])}; p0 = p1; p1 = p2; p2 = cur[t]; }
            if (r0 < MP) { if (((r0 + 8) & (TP - 1)) == 0) { const int b = r0 >> 11; f32x4* o = (f32x4*)(out + O_CONVP) + (size_t)b * 3 * 512 + c4; o[0] = cur[5]; o[512] = cur[6]; o[1024] = cur[7]; } }
            else { const int b = (r0 - MP) >> 3; f32x4* o = (f32x4*)(out + O_CONVS) + (size_t)b * 3 * 512 + c4; o[0] = cur[5]; o[512] = cur[6]; o[1024] = cur[7]; }
        }
        { OrderScores S{(const char*)Qb, (const char*)Kb, G, bx}; EpiScores E{ACAT}; pg8::gemm_phase(lds, 256, 256, S, E); }
        { OrderUT S{(const char*)BCAT, (const char*)KTD, G, bx}; EpiUT E{(bf16*)UT}; pg8::gemm_phase(lds, 512, 256, S, E); }
        } else {
        for (int it = gt; it < (M / 8) * 512; it += NGT) { const int rc = it >> 9, c4 = it & 511, r0 = rc * 8;
            const f32x4 w0 = ((const f32x4*)conv_w)[c4], w1 = ((const f32x4*)conv_w)[512 + c4], w2 = ((const f32x4*)conv_w)[1024 + c4], w3 = ((const f32x4*)conv_w)[1536 + c4], cb = ((const f32x4*)conv_b)[c4];
            const u32x2* xa4 = (const u32x2*)XA + c4; f32x4 p0, p1, p2; const f32x4 z = {0.f, 0.f, 0.f, 0.f};
#define XA_ROW(r) ({ const u32x2 w_ = xa4[(size_t)(r) * 512]; (f32x4){bflo(w_.x), bfhi(w_.x), bflo(w_.y), bfhi(w_.y)}; })
            if (r0 < MP) { if ((r0 & (TP - 1)) == 0) { p0 = z; p1 = z; p2 = z; } else { p0 = XA_ROW(r0 - 3); p1 = XA_ROW(r0 - 2); p2 = XA_ROW(r0 - 1); } }
            else { const int b = (r0 - MP) >> 3; const f32x4* sc = (const f32x4*)state_conv + (size_t)b * 3 * 512 + c4; p0 = sc[0]; p1 = sc[512]; p2 = sc[1024]; }
            f32x4 cur[8];
#pragma unroll
            for (int t = 0; t < 8; ++t) cur[t] = XA_ROW(r0 + t);
#undef XA_ROW
#pragma unroll
            for (int t = 0; t < 8; ++t) { const f32x4 y = cb + w0 * p0 + w1 * p1 + w2 * p2 + w3 * cur[t];
                ((u32x2*)XC)[(size_t)(r0 + t) * 512 + c4] = (u32x2){pk2(y[0], y[1]), pk2(y[2], y[3])}; p0 = p1; p1 = p2; p2 = cur[t]; }
            if (r0 < MP) { if (((r0 + 8) & (TP - 1)) == 0) { const int b = r0 >> 11; f32x4* o = (f32x4*)(out + O_CONVP) + (size_t)b * 3 * 512 + c4; o[0] = cur[5]; o[512] = cur[6]; o[1024] = cur[7]; } }
            else { const int b = (r0 - MP) >> 3; f32x4* o = (f32x4*)(out + O_CONVS) + (size_t)b * 3 * 512 + c4; o[0] = cur[5]; o[512] = cur[6]; o[1024] = cur[7]; }
        }
        { OrderScores S{(const char*)Qb, (const char*)Kb, G, bx}; EpiScores E{ACAT}; pg8::gemm_phase(lds, 256, 256, S, E); }
        { OrderUT S{(const char*)BCAT, (const char*)KTD, G, bx}; EpiUT E{(bf16*)UT}; pg8::gemm_phase(lds, 512, 256, S, E); }
        {
            LAS float* tab = (LAS float*)lds;
            LAS float* red = (LAS float*)(lds + 16384);
            LAS float* scs = (LAS float*)(lds + 16384 + 65536);
            for (int un = vcu; un < NBS * NH; un += G) {
                const int b = un >> 3, hh = un & 7; const float l2g = log2gamma(hh);
                const bf16* q = Qb + (size_t)32 * 2048 * 256 + (size_t)un * 2048; const bf16* k = Kb + (size_t)32 * 2048 * 256 + (size_t)un * 2048; const bf16* vt = VTS + (size_t)un * 4096;
                const float* S0 = state_ret + (size_t)un * 131072; float* Sn = out + O_RETS + (size_t)un * 131072;
                { const int dk = tid >> 1, which = tid & 1; const bf16* src = which ? k : q;
#pragma unroll
                  for (int i = 0; i < 8; ++i) tab[dk * 16 + which * 8 + i] = bf1(src[i * 256 + dk]) * fast_exp2((float)(which ? 7 - i : i + 1) * l2g); }
                { const int i = wave;
                  const u32x2 qw = ((const u32x2*)(q + i * 256))[lane]; const float q0 = bflo(qw.x), q1 = bfhi(qw.x), q2 = bflo(qw.y), q3 = bfhi(qw.y);
                  for (int j = 0; j < 8; ++j) { const u32x2 kw = ((const u32x2*)(k + j * 256))[lane];
                      float d = q0 * bflo(kw.x) + q1 * bfhi(kw.x) + q2 * bflo(kw.y) + q3 * bfhi(kw.y); d = wave_sum(d);
                      if (lane == 0) scs[i * 8 + j] = (j <= i) ? d * fast_exp2((float)(i - j) * l2g) : 0.0f; } }
                __syncthreads();
                const int dkq = tid >> 7, dv4 = tid & 127;
                float vv[4][8];
#pragma unroll
                for (int e = 0; e < 4; ++e) { const u32x4 w = *(const u32x4*)(vt + (size_t)(4 * dv4 + e) * 8);
                    vv[e][0] = bflo(w.x); vv[e][1] = bfhi(w.x); vv[e][2] = bflo(w.y); vv[e][3] = bfhi(w.y); vv[e][4] = bflo(w.z); vv[e][5] = bfhi(w.z); vv[e][6] = bflo(w.w); vv[e][7] = bfhi(w.w); }
                f32x4 cross[8];
#pragma unroll
                for (int i = 0; i < 8; ++i) cross[i] = (f32x4){0.f, 0.f, 0.f, 0.f};
                const float g8 = fast_exp2(8.0f * l2g);
                for (int it0 = 0; it0 < 64; it0 += 16) {
                    f32x4 sv[16];
#pragma unroll
                    for (int q2 = 0; q2 < 16; ++q2) sv[q2] = __builtin_nontemporal_load((const f32x4*)(S0 + (size_t)(4 * (it0 + q2) + dkq) * 512) + dv4);
#pragma unroll
                    for (int q2 = 0; q2 < 16; ++q2) { const int dk = 4 * (it0 + q2) + dkq; const f32x4 s = sv[q2];
                        const LAS f32x4* tq = (const LAS f32x4*)(tab + dk * 16); const f32x4 qa = tq[0], qb = tq[1], ka = tq[2], kb = tq[3];
                        cross[0] += qa[0] * s; cross[1] += qa[1] * s; cross[2] += qa[2] * s; cross[3] += qa[3] * s; cross[4] += qb[0] * s; cross[5] += qb[1] * s; cross[6] += qb[2] * s; cross[7] += qb[3] * s;
                        f32x4 sn = g8 * s;
#pragma unroll
                        for (int e = 0; e < 4; ++e) sn[e] += ka[0] * vv[e][0] + ka[1] * vv[e][1] + ka[2] * vv[e][2] + ka[3] * vv[e][3] + kb[0] * vv[e][4] + kb[1] * vv[e][5] + kb[2] * vv[e][6] + kb[3] * vv[e][7];
                        __builtin_nontemporal_store(sn, (f32x4*)(Sn + (size_t)dk * 512) + dv4); } }
#pragma unroll
                for (int i = 0; i < 8; ++i) *(LAS f32x4*)(red + ((dkq * 8 + i) * 512 + 4 * dv4)) = cross[i];
                __syncthreads();
                { const int dv = tid; const u32x4 w = *(const u32x4*)(vt + (size_t)dv * 8);
                  const float v[8] = {bflo(w.x), bfhi(w.x), bflo(w.y), bfhi(w.y), bflo(w.z), bfhi(w.z), bflo(w.w), bfhi(w.w)};
                  float o[8];
#pragma unroll
                  for (int i = 0; i < 8; ++i) { float a = (red[(0 * 8 + i) * 512 + dv] + red[(1 * 8 + i) * 512 + dv]) + (red[(2 * 8 + i) * 512 + dv] + red[(3 * 8 + i) * 512 + dv]);
#pragma unroll
                      for (int j = 0; j < 8; ++j) a += scs[i * 8 + j] * v[j];
                      o[i] = a; const float ss = wave_sum(a * a); if (lane == 0) scs[64 + wave * 8 + i] = ss; }
                  __syncthreads();
                  const float gn = ret_norm[hh * 512 + dv];
#pragma unroll
                  for (int i = 0; i < 8; ++i) { float tot = 0.f;
#pragma unroll
                      for (int w8 = 0; w8 < 8; ++w8) tot += scs[64 + w8 * 8 + i];
                      const float rstd = 1.0f / sqrtf(tot * (1.0f / 512.0f) + EPS); const size_t off = (size_t)(MP + b * 8 + i) * VD + hh * 512 + dv;
                      ((unsigned char*)OB)[off] = (unsigned char)(f2fp8x4(__builtin_amdgcn_fmed3f(o[i] * rstd * gn * bf1(SG[off]) * O8_SCALE, -440.0f, 440.0f), 0.f, 0.f, 0.f) & 255u); } }
                __syncthreads();
            }
        }
        }
    }
    SEAM(5);
    if (IN(6)) {
        { OrderLru S{(const char*)XC, (const char*)WLRU, G, bx}; EpiLru E{XC, lru_ba, lru_bx, lru_lambda, AA, BB}; pg8::gemm_phase(lds, D, 256, S, E); }
        if (bx >= 576 - 2 * G) convert(R_W2A0, R_W2D0, (bx - (576 - 2 * G)) * NWAVES + wave, (G - (576 - 2 * G)) * NWAVES);
        for (int wt = gw; wt < 32 * 32 * 16; wt += NGW) { const int bh = wt >> 9, dvb = (wt >> 4) & 31, dkb = wt & 15;
            const int dv = dvb * 16 + (lane & 15), dk0 = dkb * 16 + (lane >> 4) * 4; const float g256 = fast_exp2(256.0f * log2gamma(bh & 7));
            f32x4 Sv = {0.f, 0.f, 0.f, 0.f}, uu[8];
#pragma unroll
            for (int c = 0; c < 8; ++c) { const u32x2 w = *(const u32x2*)((const bf16*)UT + (((size_t)bh * 8 + c) * 512 + dv) * 256 + dk0); uu[c] = (f32x4){bflo(w.x), bfhi(w.x), bflo(w.y), bfhi(w.y)}; }
#pragma unroll
            for (int c = 0; c < 8; ++c) { const size_t bhc = (size_t)bh * 8 + c;
                *(u32x2*)(BCAT + (bhc * 512 + dv) * 512 + 256 + dk0) = (u32x2){pk2(Sv[0], Sv[1]), pk2(Sv[2], Sv[3])};
                Sv = g256 * Sv + uu[c]; }
            float* o = out + O_RETP + ((size_t)bh * 256 + dk0) * 512 + dv;
            o[0] = Sv[0]; o[512] = Sv[1]; o[1024] = Sv[2]; o[1536] = Sv[3]; }
    }
    SEAM(6);
    if (IN(7)) {
        for (int it = gt; it < 2 * 65536; it += NGT) {
            if (it < 65536) { const int s = it >> 9, c4 = it & 511; const size_t r0 = (size_t)s * 64;
                f32x4 h = {0.f, 0.f, 0.f, 0.f}, P = {1.f, 1.f, 1.f, 1.f};
                for (int t0 = 0; t0 < 64; t0 += 8) { f32x4 av[8], bv[8];
#pragma unroll
                    for (int t = 0; t < 8; ++t) { const u32x2 wa = ((const u32x2*)AA)[(r0 + t0 + t) * 512 + c4], wb = ((const u32x2*)BB)[(r0 + t0 + t) * 512 + c4];
                        av[t] = (f32x4){1.0f - bflo(wa.x), 1.0f - bfhi(wa.x), 1.0f - bflo(wa.y), 1.0f - bfhi(wa.y)}; bv[t] = (f32x4){bflo(wb.x), bfhi(wb.x), bflo(wb.y), bfhi(wb.y)}; }
#pragma unroll
                    for (int t = 0; t < 8; ++t) { h = av[t] * h + bv[t]; P = P * av[t];
                        ((u32x2*)HL)[(r0 + t0 + t) * 512 + c4] = (u32x2){pk2(h[0], h[1]), pk2(h[2], h[3])}; ((u32x2*)PC)[(r0 + t0 + t) * 512 + c4] = (u32x2){pk2(P[0], P[1]), pk2(P[2], P[3])}; } }
                ((f32x4*)AGA)[(size_t)s * 512 + c4] = P; ((f32x4*)AGB)[(size_t)s * 512 + c4] = h;
            } else { const int b = (it - 65536) >> 9, c4 = it & 511; const size_t r0 = (size_t)MP + b * 8;
                f32x4 h = ((const f32x4*)state_lru)[(size_t)b * 512 + c4];
                f32x4 av[8], bv[8]; u32x2 gv[8];
#pragma unroll
                for (int t = 0; t < 8; ++t) { const u32x2 wa = ((const u32x2*)AA)[(r0 + t) * 512 + c4], wb = ((const u32x2*)BB)[(r0 + t) * 512 + c4]; gv[t] = ((const u32x2*)GA)[(r0 + t) * 512 + c4];
                    av[t] = (f32x4){1.0f - bflo(wa.x), 1.0f - bfhi(wa.x), 1.0f - bflo(wa.y), 1.0f - bfhi(wa.y)}; bv[t] = (f32x4){bflo(wb.x), bfhi(wb.x), bflo(wb.y), bfhi(wb.y)}; }
#pragma unroll
                for (int t = 0; t < 8; ++t) { h = av[t] * h + bv[t]; const u32x2 gw2 = gv[t];
                    ((u32x2*)OA)[(r0 + t) * 512 + c4] = (u32x2){pk2(h[0] * bflo(gw2.x), h[1] * bfhi(gw2.x)), pk2(h[2] * bflo(gw2.y), h[3] * bfhi(gw2.y))}; }
                ((f32x4*)(out + O_LRUS))[(size_t)b * 512 + c4] = h; }
        }
        { OrderO S{(const char*)ACAT, (const char*)BCAT, G, bx, vcu}; EpiO E{OF}; pg8::gemm_phase(lds, 512, 512, S, E); }
    }
    SEAM(7);
    if (IN(8)) {
        for (int it = gt; it < 65536; it += NGT) { const int s = it >> 9, c4 = it & 511, b = s >> 5; const size_t r0 = (size_t)s * 64;
            f32x4 carry = {0.f, 0.f, 0.f, 0.f};
#pragma unroll 8
            for (int sp = b * 32; sp < s; ++sp) carry = ((const f32x4*)AGA)[(size_t)sp * 512 + c4] * carry + ((const f32x4*)AGB)[(size_t)sp * 512 + c4];
            f32x4 h = {0.f, 0.f, 0.f, 0.f};
            for (int t0 = 0; t0 < 64; t0 += 16) { u32x2 hv[16], pv[16], gv[16];
#pragma unroll
                for (int t = 0; t < 16; ++t) { hv[t] = ((const u32x2*)HL)[(r0 + t0 + t) * 512 + c4]; pv[t] = ((const u32x2*)PC)[(r0 + t0 + t) * 512 + c4]; gv[t] = ((const u32x2*)GA)[(r0 + t0 + t) * 512 + c4]; }
#pragma unroll
                for (int t = 0; t < 16; ++t) { const u32x2 hw = hv[t], pw = pv[t], gw2 = gv[t];
                    h = (f32x4){bflo(hw.x) + bflo(pw.x) * carry[0], bfhi(hw.x) + bfhi(pw.x) * carry[1], bflo(hw.y) + bflo(pw.y) * carry[2], bfhi(hw.y) + bfhi(pw.y) * carry[3]};
                    ((u32x2*)OA)[(r0 + t0 + t) * 512 + c4] = (u32x2){pk2(h[0] * bflo(gw2.x), h[1] * bfhi(gw2.x)), pk2(h[2] * bflo(gw2.y), h[3] * bfhi(gw2.y))}; } }
            if ((s & 31) == 31) ((f32x4*)(out + O_LRUP))[(size_t)b * 512 + c4] = h; }
        const bool bal8 = (G == 256); const bool hv8 = vcu < 128;
        const int n8 = bal8 ? (hv8 ? 2 : 14) : (MP * NH / 4 + NGW - 1 - gw) / NGW, w8 = bal8 ? ((hv8 ? vcu : vcu - 128) * NWAVES + wave) : gw, b8 = bal8 ? (hv8 ? 0 : 2048) : 0, s8 = bal8 ? 1024 : NGW;
        for (int q8 = 0; q8 < n8; ++q8) { const int wi0 = (b8 + w8 + q8 * s8) * 4;
            f32x4 v0[4], v1[4]; u32x2 s0[4], s1[4];
#pragma unroll
            for (int q2 = 0; q2 < 4; ++q2) { const int wi = wi0 + q2, row = wi >> 3, hh = wi & 7; const size_t base = (size_t)row * VD + hh * 512;
                const u32x2 o0 = ((const u32x2*)(OF + base))[lane], o1 = ((const u32x2*)(OF + base))[64 + lane];
                v0[q2] = (f32x4){bflo(o0.x), bfhi(o0.x), bflo(o0.y), bfhi(o0.y)}; v1[q2] = (f32x4){bflo(o1.x), bfhi(o1.x), bflo(o1.y), bfhi(o1.y)}; s0[q2] = ((const u32x2*)(SG + base))[lane]; s1[q2] = ((const u32x2*)(SG + base))[64 + lane]; }
#pragma unroll
            for (int q2 = 0; q2 < 4; ++q2) { const int wi = wi0 + q2, row = wi >> 3, hh = wi & 7; const size_t base = (size_t)row * VD + hh * 512;
                const f32x4 a0 = v0[q2], a1 = v1[q2];
                const float ss = (a0[0] * a0[0] + a0[1] * a0[1]) + (a0[2] * a0[2] + a0[3] * a0[3]) + (a1[0] * a1[0] + a1[1] * a1[1]) + (a1[2] * a1[2] + a1[3] * a1[3]);
                const float rstd = 1.0f / sqrtf(wave_sum(ss) * (1.0f / 512.0f) + EPS);
                const f32x4 g0 = ((const f32x4*)(ret_norm + hh * 512))[lane], g1 = ((const f32x4*)(ret_norm + hh * 512))[64 + lane];
                const float rs8 = rstd * O8_SCALE;
#define O8C(x) __builtin_amdgcn_fmed3f((x), -440.0f, 440.0f)
                ((unsigned*)((unsigned char*)OB + base))[lane] = f2fp8x4(O8C(a0[0] * rs8 * g0[0] * bflo(s0[q2].x)), O8C(a0[1] * rs8 * g0[1] * bfhi(s0[q2].x)), O8C(a0[2] * rs8 * g0[2] * bflo(s0[q2].y)), O8C(a0[3] * rs8 * g0[3] * bfhi(s0[q2].y)));
                ((unsigned*)((unsigned char*)OB + base))[64 + lane] = f2fp8x4(O8C(a1[0] * rs8 * g1[0] * bflo(s1[q2].x)), O8C(a1[1] * rs8 * g1[1] * bfhi(s1[q2].x)), O8C(a1[2] * rs8 * g1[2] * bflo(s1[q2].y)), O8C(a1[3] * rs8 * g1[3] * bfhi(s1[q2].y)));
#undef O8C
            } }
    }
    SEAM(8);
    if (IN(9)) {
        float* slabA = UT; float* slabB = (float*)((bf16*)UT + (size_t)8 * MS * D);
        { pg8::SplitOrder S; S.init(OA, (size_t)256 * D * 2, WPA, (size_t)256 * D * 2, D / 64, G, bx); EpiGate<0> E{SA, (bf16*)TMP, nullptr, slabA, 1.0f}; pg8::gemm_phase(lds, D, D, S, E); }
        { pg8::SplitOrder S; S.init(OB, (size_t)256 * VD, WPB, (size_t)256 * VD, VD / 128, G, bx); EpiGate<1> E{SB, (bf16*)TMP, MG, slabB, 1.0f / (O8_SCALE * W8_SCALE)};
          pg8::gemm_phase<EpiGate<1>, pg8::SplitOrder, 1>(lds, VD / 2, VD / 2, S, E); }
        xcd_barrier(bar);
        for (int q = gw; q < 2 * MS; q += NGW) { const int r = q >> 1, j0 = (q & 1) * 2; const size_t ro = (size_t)(MP + r) * D;
#pragma unroll 1
            for (int j = j0; j < j0 + 2; ++j) { const int c8 = lane + 64 * j;
                f32x4 a0 = {0.f, 0.f, 0.f, 0.f}, a1 = a0, b0 = a0, b1 = a0;
#pragma unroll
                for (int k = 0; k < 8; ++k) { const u32x4 wa = *(const u32x4*)((const bf16*)slabA + ((size_t)k * MS + r) * D + 8 * c8), wb = *(const u32x4*)((const bf16*)slabB + ((size_t)k * MS + r) * D + 8 * c8);
                    a0 += (f32x4){bflo(wa.x), bfhi(wa.x), bflo(wa.y), bfhi(wa.y)}; a1 += (f32x4){bflo(wa.z), bfhi(wa.z), bflo(wa.w), bfhi(wa.w)};
                    b0 += (f32x4){bflo(wb.x), bfhi(wb.x), bflo(wb.y), bfhi(wb.y)}; b1 += (f32x4){bflo(wb.z), bfhi(wb.z), bflo(wb.w), bfhi(wb.w)}; }
                const u32x4 ga = *(const u32x4*)(SA + ro + 8 * c8), gb = *(const u32x4*)(SB + ro + 8 * c8);
                u32x4 w;
                w.x = cvt_pk_bf16(bflo(ga.x) * a0[0] + bflo(gb.x) * b0[0], bfhi(ga.x) * a0[1] + bfhi(gb.x) * b0[1]);
                w.y = cvt_pk_bf16(bflo(ga.y) * a0[2] + bflo(gb.y) * b0[2], bfhi(ga.y) * a0[3] + bfhi(gb.y) * b0[3]);
                w.z = cvt_pk_bf16(bflo(ga.z) * a1[0] + bflo(gb.z) * b1[0], bfhi(ga.z) * a1[1] + bfhi(gb.z) * b1[1]);
                w.w = cvt_pk_bf16(bflo(ga.w) * a1[2] + bflo(gb.w) * b1[2], bfhi(ga.w) * a1[3] + bfhi(gb.w) * b1[3]);
                *(u32x4*)(MG + ro + 8 * c8) = w; } }
    }
    SEAM(9);
    if (IN(10)) { pg8::SplitOrder S; S.init(MG, (size_t)256 * D * 2, WOUT, (size_t)256 * D * 2, D / 64, G, bx); EpiResid<true> E{X, X, 1.0f, SLAB, 1.0f}; pg8::gemm_phase(lds, D, D, S, E); }
    SEAM(10);
    if (IN(11)) { for (int k_ = 0; k_ < rnk_; ++k_) { const int m = ROWMAP(k_); if (m < MP) rms_row_q8<true>(X + (size_t)m * D, ffn2_norm, U8 + (size_t)m * D, RS + m, lane);
            else rms_row_slab_q8<true>(X + (size_t)m * D, (const float*)((const bf16*)SLAB + (size_t)(m - MP) * D), 1.0f, X + (size_t)m * D, ffn2_norm, U8 + (size_t)m * D, RS + m, lane); } }
    SEAM(11);
    if (IN(12)) { pg8::TileOrder S; S.init(U8, (size_t)256 * D, W2A, (size_t)256 * D, 36, 44, D / 128, G, bx); EpiSwigluQ8 E{(unsigned char*)HB, RS, (const unsigned*)(ctl + CW_CM2)}; pg8::gemm_phase<EpiSwigluQ8, pg8::TileOrder, 2>(lds, D / 2, D / 2, S, E);
        if (bx >= 1584 - 6 * 256) { const int wk = (bx - (1584 - 6 * 256)) * NWAVES + wave, nwk = (G - (1584 - 6 * 256)) * NWAVES;
            convert(R_W2D0, R_WIN0, wk, nwk); convert(R_WPG0, R_LRU0, wk, nwk); } }
    SEAM(12);
    if (IN(13)) { pg8::SplitOrder S; S.init(HB, (size_t)256 * FF, W2D, (size_t)256 * FF, FF / 128, G, bx); EpiResid<true> E{X, X, 0.5f / (H8_SCALE * W8_SCALE), SLAB, 1.0f / (H8_SCALE * W8_SCALE)}; pg8::gemm_phase<EpiResid<true>, pg8::SplitOrder, 1>(lds, FF / 2, FF / 2, S, E); }
    SEAM(13);
    if (IN(14)) { for (int k_ = 0; k_ < rnk_; ++k_) { const int m = ROWMAP(k_); if (m < MP) rms_row_q8<true>(X + (size_t)m * D, ple_norm, U8 + (size_t)m * D, RS + m, lane);
            else rms_row_slab_q8<true>(X + (size_t)m * D, (const float*)((const bf16*)SLAB + (size_t)(m - MP) * D), 0.5f, X + (size_t)m * D, ple_norm, U8 + (size_t)m * D, RS + m, lane); } }
    SEAM(14);
    if (IN(15)) {
        { pg8::TileOrder S; S.init(PEB, (size_t)256 * PLE * 2, WPP, (size_t)256 * PLE * 2, 36, 8, PLE / 64, G, bx); EpiStoreF32 E{(bf16*)TMP2}; pg8::gemm_phase(lds, PLE, PLE, S, E); }
        { pg8::SplitOrder S; S.init(U8, (size_t)256 * D, WPG, (size_t)256 * D, D / 128, G, bx); EpiPle E{ple_bg, (const bf16*)TMP2, X, SLAB, RS, (const unsigned*)(ctl + CW_CM4)};
          pg8::gemm_phase<EpiPle, pg8::SplitOrder, 2>(lds, D / 2, D / 2, S, E); }
    }
    SEAM(15);
    if (IN(16)) { for (int k_ = 0; k_ < rnk_; ++k_) { const int m = ROWMAP(k_); if (m < MP) rms_row_f32(X + (size_t)m * D, final_norm, out + O_Y + (size_t)m * D, lane);
            else rms_row_ple_f32(X + (size_t)m * D, (const float*)((const bf16*)SLAB + (size_t)(m - MP) * D), ple_bg, (const bf16*)TMP2 + (size_t)m * D, final_norm, out + O_Y + (size_t)m * D, lane); } }
#undef IN
#undef SEAM
}

#undef x_prompt
#undef x_sample
#undef p_prompt
#undef p_sample
#undef state_lru
#undef state_conv
#undef state_ret
#undef ffn1_norm
#undef mix_norm
#undef b_in
#undef conv_w
#undef conv_b
#undef lru_ba
#undef lru_bx
#undef lru_lambda
#undef ret_norm
#undef ffn2_norm
#undef ple_norm
#undef ple_bg
#undef final_norm
#undef out
#undef W1A
#undef W1D
#undef W2A
#undef W2D
#undef WIN
#undef WPA
#undef WPB
#undef WOUT
#undef WPG
#undef WPP
#undef WLRU
#undef COS
#undef SIN
#undef U
#undef HB
#undef X
#undef XA
#undef SLAB
#undef GA
#undef Qb
#undef Kb
#undef ACAT
#undef BCAT
#undef KTD
#undef VTS
#undef SG
#undef SA
#undef SB
#undef XC
#undef AA
#undef BB
#undef HL
#undef PC
#undef AGA
#undef AGB
#undef OA
#undef UT
#undef OF
#undef OB
#undef TMP
#undef TMP2
#undef MG
#undef PEB
#undef ROWMAP
#undef U8
#undef WIN8
#undef RS
extern "C" void kernel_launch(void* const* d_in, const int* in_sizes, int n_in, void* d_out, int out_size, void* d_ws, size_t ws_size, hipStream_t stream) {
    static int grid = 0;
    if (grid == 0) {
        if (n_in != 34 || (size_t)out_size != O_END || ws_size < WS_END) { fprintf(stderr, "kernel_launch: unexpected shapes: n_in %d out %d ws %zu (need %zu)\n", n_in, out_size, ws_size, (size_t)WS_END); grid = -1; return; }
        int dev = 0, cus = 0, per_cu = 0;
        if (hipGetDevice(&dev) != hipSuccess || hipDeviceGetAttribute(&cus, hipDeviceAttributeMultiprocessorCount, dev) != hipSuccess) { grid = -1; return; }
        if (hipFuncSetAttribute((const void*)mega_fwd, hipFuncAttributeMaxDynamicSharedMemorySize, LDS_BYTES) != hipSuccess) { fprintf(stderr, "kernel_launch: hipFuncSetAttribute failed\n"); grid = -1; return; }
        if (hipOccupancyMaxActiveBlocksPerMultiprocessor(&per_cu, (const void*)mega_fwd, NWAVES * 64, LDS_BYTES) != hipSuccess || per_cu < 1) fprintf(stderr, "kernel_launch: occupancy query reports %d\n", per_cu);
        (void)hipGetLastError();
        grid = cus;
    }
    if (grid < 0) return;
    if (hipMemsetAsync((char*)d_ws + WS_CTL, 0, CTL_ZERO_BYTES, stream) != hipSuccess) return;
    Args a{};
    for (int i = 0; i < 34; ++i) a.in[i] = (const float*)d_in[i];
    a.out = (float*)d_out; a.ws = (unsigned char*)d_ws;
    a.ph_lo = 0; a.ph_hi = NPHASE;
    hipLaunchKernelGGL(mega_fwd, dim3(grid), dim3(NWAVES * 64), LDS_BYTES, stream, a);
}
```

```cpp
#include <hip/hip_runtime.h>
#include <cstdio>
#include <cstdint>

#define LAS __attribute__((address_space(3)))
#define GAS __attribute__((address_space(1)))
typedef unsigned short bf16;
typedef short bf16x8 __attribute__((ext_vector_type(8)));
typedef float f32x4 __attribute__((ext_vector_type(4)));
typedef float f32x2 __attribute__((ext_vector_type(2)));
typedef unsigned u32x4 __attribute__((ext_vector_type(4)));
typedef unsigned u32x2 __attribute__((ext_vector_type(2)));
typedef GAS unsigned gu32;

constexpr int D = 2048, FF = 5632, NIN = 20480, MP = 8192, MS = 1024, M = MP + MS, TP = 2048, NBS = 128, NH = 8, DK = 256, DV = 512, VD = 4096, PLE = 256;
constexpr float EPS = 1e-6f;
constexpr int NWAVES = 8;

constexpr size_t O_Y = 0, O_LRUP = 18874368, O_CONVP = 18882560, O_RETP = 18907136, O_LRUS = 23101440, O_CONVS = 23363584, O_RETS = 24150016, O_END = 158367744;

constexpr size_t MiB = 1u << 20;
constexpr size_t WS_CTL = 0, CTL_ZERO_BYTES = 1 * MiB;
constexpr size_t WS_W1A = 1 * MiB;
constexpr size_t WS_W1D = WS_W1A + 44 * MiB;
constexpr size_t WS_W2A = WS_W1D + 22 * MiB;
constexpr size_t WS_W2D = WS_W2A + 44 * MiB;
constexpr size_t WS_WIN = WS_W2D + 22 * MiB;
constexpr size_t WS_WPA = WS_WIN + 80 * MiB;
constexpr size_t WS_WPB = WS_WPA + 8 * MiB;
constexpr size_t WS_WOUT = WS_WPB + 16 * MiB;
constexpr size_t WS_WPG = WS_WOUT + 8 * MiB;
constexpr size_t WS_WPP = WS_WPG + 8 * MiB;
constexpr size_t WS_WLRU = WS_WPP + 1 * MiB;
constexpr size_t WS_COS = WS_WLRU + 2 * MiB;
constexpr size_t WS_SIN = WS_COS + 2 * MiB;
constexpr size_t WS_U = WS_SIN + 2 * MiB;
constexpr size_t WS_HB = WS_U + 36 * MiB;
constexpr size_t WS_X = WS_HB + 99 * MiB;
constexpr size_t WS_XA = WS_X + 72 * MiB;
constexpr size_t WS_GA = WS_XA + 72 * MiB;
constexpr size_t WS_Q = WS_GA + 36 * MiB;
constexpr size_t WS_K = WS_Q + 36 * MiB;
constexpr size_t WS_ACAT = WS_K + 36 * MiB;
constexpr size_t WS_BCAT = WS_ACAT + 64 * MiB;
constexpr size_t WS_KTD = WS_BCAT + 128 * MiB;
constexpr size_t WS_VTS = WS_KTD + 32 * MiB;
constexpr size_t WS_SG = WS_VTS + 8 * MiB;
constexpr size_t WS_SA = WS_SG + 72 * MiB;
constexpr size_t WS_SB = WS_SA + 36 * MiB;
constexpr size_t WS_XC = WS_SB + 36 * MiB;
constexpr size_t WS_AA = WS_XC + 36 * MiB;
constexpr size_t WS_BB = WS_AA + 72 * MiB;
constexpr size_t WS_HL = WS_BB + 72 * MiB;
constexpr size_t WS_PC = WS_HL + 32 * MiB;
constexpr size_t WS_AGA = WS_PC + 32 * MiB;
constexpr size_t WS_AGB = WS_AGA + 1 * MiB;
constexpr size_t WS_OA = WS_AGB + 1 * MiB;
constexpr size_t WS_UT = WS_OA + 36 * MiB;
constexpr size_t WS_OF = WS_UT + 128 * MiB;
constexpr size_t WS_OB = WS_OF + 128 * MiB;
constexpr size_t WS_TMP = WS_OB + 72 * MiB;
constexpr size_t WS_TMP2 = WS_TMP + 72 * MiB;
constexpr size_t WS_MG = WS_TMP2 + 72 * MiB;
constexpr size_t WS_PE = WS_MG + 36 * MiB;
constexpr size_t WS_U8 = WS_PE + 5 * MiB;
constexpr size_t WS_WIN8 = WS_U8 + 19 * MiB;
constexpr size_t WS_RS = WS_WIN8 + 40 * MiB;
constexpr size_t WS_END = WS_RS + 1 * MiB;

constexpr int CW_CM1 = 65536, CW_CM2 = CW_CM1 + 2 * FF, CW_CM3 = CW_CM2 + 2 * FF, CW_CM4 = CW_CM3 + NIN;
constexpr int CW_BAR = 4096;

constexpr int RING_BYTES = 131072, LDSCTL_OFF = RING_BYTES, MISC_OFF = LDSCTL_OFF + 320, XPOSE_OFF = RING_BYTES + 2048, LDS_BYTES = 147456;

#define RLX_AGENT __ATOMIC_RELAXED, __HIP_MEMORY_SCOPE_AGENT
#define LDS_WAIT() asm volatile("s_waitcnt lgkmcnt(0)" ::: "memory")
#define VM_WAIT() asm volatile("s_waitcnt vmcnt(0)" ::: "memory")
__device__ __forceinline__ unsigned f2bf(float f) { unsigned u = __builtin_bit_cast(unsigned, f); return (u + 0x7fffu + ((u >> 16) & 1u)) >> 16; }
__device__ __forceinline__ unsigned pk2(float lo, float hi) { return f2bf(lo) | (f2bf(hi) << 16); }
__device__ __forceinline__ float bflo(unsigned w) { return __builtin_bit_cast(float, w << 16); }
__device__ __forceinline__ float bfhi(unsigned w) { return __builtin_bit_cast(float, w & 0xffff0000u); }
__device__ __forceinline__ float bf1(bf16 v) { return __builtin_bit_cast(float, ((unsigned)v) << 16); }
typedef __bf16 bf16x2_t __attribute__((ext_vector_type(2)));
__device__ __forceinline__ unsigned cvt_pk_bf16(float lo, float hi) { const f32x2 v = {lo, hi}; const bf16x2_t b = __builtin_convertvector(v, bf16x2_t); return __builtin_bit_cast(unsigned, b); }
typedef int v8i __attribute__((ext_vector_type(8)));
typedef int v4i __attribute__((ext_vector_type(4)));
__device__ __forceinline__ unsigned f2fp8x4(float a, float b, float c, float d) { int w = 0; w = __builtin_amdgcn_cvt_pk_fp8_f32(a, b, w, false); w = __builtin_amdgcn_cvt_pk_fp8_f32(c, d, w, true); return (unsigned)w; }
constexpr float H8_SCALE = 8.0f;
constexpr float O8_SCALE = 8.0f;
constexpr float W8_SCALE = 64.0f;
__device__ __forceinline__ float fast_exp2(float x) { return __builtin_amdgcn_exp2f(x); }
__device__ __forceinline__ float fast_rcp(float x) { return __builtin_amdgcn_rcpf(x); }
__device__ __forceinline__ float sigmoidf_(float x) { return fast_rcp(1.0f + fast_exp2(-1.44269504089f * x)); }
__device__ __forceinline__ float siluf_(float x) { return x * sigmoidf_(x); }
__device__ __forceinline__ float gelu_tanh_(float x) { const float u = 0.7978845608028654f * (x + 0.044715f * x * x * x); return x * fast_rcp(1.0f + fast_exp2(-2.88539008178f * u)); }
#define DPPF(old, x, ctrl, rmask) __builtin_bit_cast(float, __builtin_amdgcn_update_dpp(__builtin_bit_cast(int, (float)(old)), __builtin_bit_cast(int, (float)(x)), (ctrl), (rmask), 0xf, false))
__device__ __forceinline__ float wave_sum(float v) {
    v += DPPF(0.f, v, 0xB1, 0xf); v += DPPF(0.f, v, 0x4E, 0xf); v += DPPF(0.f, v, 0x141, 0xf); v += DPPF(0.f, v, 0x140, 0xf);
    v += DPPF(0.f, v, 0x142, 0xa); v += DPPF(0.f, v, 0x143, 0xc);
    return __builtin_bit_cast(float, __builtin_amdgcn_readlane(__builtin_bit_cast(int, v), 63));
}
__device__ __forceinline__ float wave_max(float v) {
    v = fmaxf(v, DPPF(v, v, 0xB1, 0xf)); v = fmaxf(v, DPPF(v, v, 0x4E, 0xf)); v = fmaxf(v, DPPF(v, v, 0x141, 0xf)); v = fmaxf(v, DPPF(v, v, 0x140, 0xf));
    v = fmaxf(v, DPPF(v, v, 0x142, 0xa)); v = fmaxf(v, DPPF(v, v, 0x143, 0xc));
    return __builtin_bit_cast(float, __builtin_amdgcn_readlane(__builtin_bit_cast(int, v), 63));
}
__device__ __forceinline__ unsigned f2i8x4(float a, float b, float c, float d) {
    const int ia = (int)rintf(a), ib = (int)rintf(b), ic = (int)rintf(c), id = (int)rintf(d);
    return (unsigned)(ia & 255) | ((unsigned)(ib & 255) << 8) | ((unsigned)(ic & 255) << 16) | ((unsigned)id << 24); }
__device__ __forceinline__ float log2gamma(int hh) { return log1pf(-exp2f(-5.0f - (float)hh)) * 1.4426950408889634f; }

namespace pg8 {
constexpr int BM = 256, BK = 64, HALF = 128, HTB = HALF * BK * 2, STAGE_BYTES = 8 * HTB;
__host__ __device__ __forceinline__ int lds_byte(int r, int c) { const int st = (r >> 4) * 2 + (c >> 5), rr = r & 15, cc = c & 31, ob = rr * 64 + cc * 2; return st * 1024 + (ob ^ (((ob >> 9) & 1) << 5)); }
__host__ __device__ __forceinline__ void stage_rc(int b, int& R, int& C) { const int st = b / 1024, sb = b % 1024, swz = sb ^ (((sb >> 9) & 1) << 5); R = (st >> 1) * 16 + swz / 64; C = (st & 1) * 32 + (swz % 64) / 2; }
__host__ __device__ __forceinline__ int perm32(int rho) { const int n = rho >> 4, i = rho & 15; return 8 * (i >> 2) + 4 * n + (i & 3); }

struct Unit { const char* a; const char* b; int pm, pn, nt, ks; };

template <class Epi, class Sched, int MODE = 0>
__device__ __forceinline__ void gemm_phase(LAS unsigned char* lds, const int lda, const int ldb, const Sched& S, const Epi& E) {
    int tid = threadIdx.x; asm volatile("" : "+v"(tid));
    const int wid = __builtin_amdgcn_readfirstlane(tid >> 6), lane = tid & 63, wr = wid >> 2, wc = wid & 3, fr = lane & 15, fq = lane >> 4;
    unsigned voffA[2], voffB[2];
#pragma unroll
    for (int i = 0; i < 2; ++i) { int R, C; stage_rc(tid * 16 + i * 8192, R, C); const int Rb = (R & ~31) + perm32(R & 31);
        voffA[i] = (unsigned)(R * lda + C) * 2u; voffB[i] = (unsigned)(Rb * ldb + C) * 2u; }
    const size_t kstep = (size_t)(BK * 2);
    const size_t hstepA = (size_t)HALF * lda * 2, hstepB = (size_t)HALF * ldb * 2;
    const unsigned ldsw = (unsigned)wid * 1024u;
    const int aoff = lds_byte(wr * 64 + fr, fq * 8), boff = lds_byte(wc * 32 + fr, fq * 8);
#define PG8_SA(b, h) (((b) * 2 + (h)) * HTB)
#define PG8_SB(b, h) ((4 + (b) * 2 + (h)) * HTB)
#define PG8_STAGE(bufoff, gbase, voff) do { _Pragma("unroll") for (int _i = 0; _i < 2; ++_i) \
        __builtin_amdgcn_global_load_lds((const unsigned*)((const char*)(gbase) + (voff)[_i]), (LAS unsigned*)(lds + (bufoff) + ldsw + _i * 8192), 16, 0, 0); } while (0)
#define PG8_LDA(dst, b, h) do { _Pragma("unroll") for (int m = 0; m < 4; ++m) _Pragma("unroll") for (int k = 0; k < 2; ++k) dst[m][k] = *(const LAS bf16x8*)(lds + PG8_SA(b, h) + aoff + m * 2048 + k * 1024); } while (0)
#define PG8_LDB(dst, b, h) do { _Pragma("unroll") for (int n = 0; n < 2; ++n) _Pragma("unroll") for (int k = 0; k < 2; ++k) dst[n][k] = *(const LAS bf16x8*)(lds + PG8_SB(b, h) + boff + n * 2048 + k * 1024); } while (0)
#define PG8_CAT(x0, x1) __builtin_shufflevector(__builtin_bit_cast(v4i, x0), __builtin_bit_cast(v4i, x1), 0, 1, 2, 3, 4, 5, 6, 7)
#define PG8_MMA(ai, bj, At, Bt) do { __builtin_amdgcn_s_setprio(1); _Pragma("unroll") for (int m = 0; m < 4; ++m) _Pragma("unroll") for (int n = 0; n < 2; ++n) { \
        if constexpr (MODE == 1) asm volatile("v_mfma_scale_f32_16x16x128_f8f6f4 %0, %1, %2, %0, %3, %3 op_sel_hi:[0,0,0]" : "+v"(acc[ai][bj][m][n]) : "v"(PG8_CAT(Bt[n][0], Bt[n][1])), "v"(PG8_CAT(At[m][0], At[m][1])), "v"(sc8)); \
        else if constexpr (MODE == 2) { _Pragma("unroll") for (int k = 0; k < 2; ++k) acc[ai][bj][m][n] = __builtin_bit_cast(f32x4, __builtin_amdgcn_mfma_i32_16x16x64_i8(__builtin_bit_cast(v4i, Bt[n][k]), __builtin_bit_cast(v4i, At[m][k]), __builtin_bit_cast(v4i, acc[ai][bj][m][n]), 0, 0, 0)); } \
        else { _Pragma("unroll") for (int k = 0; k < 2; ++k) acc[ai][bj][m][n] = __builtin_amdgcn_mfma_f32_16x16x32_bf16(Bt[n][k], At[m][k], acc[ai][bj][m][n], 0, 0, 0); } } \
        __builtin_amdgcn_s_setprio(0); } while (0)
#define PG8_WAIT_V(n) asm volatile("s_waitcnt vmcnt(" #n ")" ::: "memory")
#define PG8_WAIT_L(n) asm volatile("s_waitcnt lgkmcnt(" #n ")" ::: "memory")
#define PG8_BAR __builtin_amdgcn_s_barrier()
#define PG8_SCHED __builtin_amdgcn_sched_barrier(0)
    Unit cur, nxt; int ui = 0;
    if (!S.next(0, cur)) return;
    [[maybe_unused]] int sc8 = 0x7F7F7F7F;
    f32x4 acc[2][2][4][2];
#pragma unroll
    for (int a = 0; a < 2; ++a)
#pragma unroll
        for (int b = 0; b < 2; ++b)
#pragma unroll
            for (int m = 0; m < 4; ++m)
#pragma unroll
                for (int n = 0; n < 2; ++n) acc[a][b][m][n] = (f32x4){0.f, 0.f, 0.f, 0.f};
    bf16x8 At[4][2], B0[2][2], B1[2][2];
    const char* cA = cur.a; const char* cB = cur.b;
    PG8_STAGE(PG8_SB(0, 0), cB, voffB); PG8_STAGE(PG8_SB(0, 1), cB + hstepB, voffB); PG8_STAGE(PG8_SA(0, 0), cA, voffA); PG8_STAGE(PG8_SA(0, 1), cA + hstepA, voffA);
    if (wr == 1) PG8_BAR;
    PG8_WAIT_V(2); PG8_BAR;
    PG8_STAGE(PG8_SB(1, 0), cB + kstep, voffB); PG8_STAGE(PG8_SA(1, 0), cA + kstep, voffA); PG8_STAGE(PG8_SB(1, 1), cB + hstepB + kstep, voffB);
    PG8_WAIT_V(6); PG8_BAR;
    for (;;) {
        const bool has_next = S.next(ui + 1, nxt);
        const char* nA = has_next ? nxt.a : cA; const char* nB = has_next ? nxt.b : cB;
        int nt = cur.nt; asm volatile("" : "+s"(nt));
        for (int t = 0; t < nt; t += 2) {
            const bool last = (t == nt - 2);
            const char* a1 = cA + (size_t)(t + 1) * kstep;
            const char* a2 = last ? nA : cA + (size_t)(t + 2) * kstep; const char* b2 = last ? nB : cB + (size_t)(t + 2) * kstep;
            const char* a3 = a2 + kstep; const char* b3 = b2 + kstep;
            PG8_LDB(B0, 0, 0); PG8_LDB(B1, 0, 1); PG8_SCHED; PG8_LDA(At, 0, 0); PG8_STAGE(PG8_SA(1, 1), a1 + hstepA, voffA);
            PG8_WAIT_V(8); PG8_WAIT_L(0); PG8_BAR; PG8_MMA(0, 0, At, B0); PG8_MMA(0, 1, At, B1); PG8_BAR; PG8_SCHED;
            PG8_LDA(At, 0, 1); PG8_STAGE(PG8_SB(0, 0), b2, voffB); PG8_STAGE(PG8_SB(0, 1), b2 + hstepB, voffB); PG8_STAGE(PG8_SA(0, 0), a2, voffA);
            PG8_WAIT_V(8); PG8_WAIT_L(0); PG8_BAR; PG8_MMA(1, 0, At, B0); PG8_MMA(1, 1, At, B1); PG8_BAR; PG8_SCHED;
            PG8_LDB(B0, 1, 0); PG8_LDB(B1, 1, 1); PG8_SCHED; PG8_LDA(At, 1, 0); PG8_STAGE(PG8_SA(0, 1), a2 + hstepA, voffA);
            PG8_WAIT_V(8); PG8_WAIT_L(0); PG8_BAR; PG8_MMA(0, 0, At, B0); PG8_MMA(0, 1, At, B1); PG8_BAR; PG8_SCHED;
            PG8_LDA(At, 1, 1); PG8_STAGE(PG8_SB(1, 0), b3, voffB); PG8_STAGE(PG8_SB(1, 1), b3 + hstepB, voffB); PG8_STAGE(PG8_SA(1, 0), a3, voffA);
            PG8_WAIT_V(8); PG8_WAIT_L(0); PG8_BAR; PG8_MMA(1, 0, At, B0); PG8_MMA(1, 1, At, B1); PG8_BAR; PG8_SCHED;
        }
        if (wr == 0) PG8_BAR;
        if constexpr (MODE == 1) asm volatile("s_nop 15\n\ts_nop 7" ::: "memory");
        E(acc, cur, wr, wc, fr, fq);
        if (!has_next) break;
#pragma unroll
        for (int a = 0; a < 2; ++a)
#pragma unroll
            for (int b = 0; b < 2; ++b)
#pragma unroll
                for (int m = 0; m < 4; ++m)
#pragma unroll
                    for (int n = 0; n < 2; ++n) acc[a][b][m][n] = (f32x4){0.f, 0.f, 0.f, 0.f};
        cur = nxt; cA = nA; cB = nB; ++ui;
        if (wr == 1) PG8_BAR;
    }
    PG8_WAIT_V(0);
    PG8_BAR;
#undef PG8_SA
#undef PG8_SB
#undef PG8_STAGE
#undef PG8_LDA
#undef PG8_LDB
#undef PG8_MMA
#undef PG8_CAT
#undef PG8_WAIT_V
#undef PG8_WAIT_L
#undef PG8_BAR
#undef PG8_SCHED
}

struct TileOrder {
    const char* A; const char* B; size_t strideA, strideB; int nM, nN, nwg, G, c, nt; int pn_s1 = 1 << 30, pn_s2 = 1 << 30, pn_a = 0, pn_b = 0, pn_c = 0;
    __device__ __forceinline__ void init(const void* A_, size_t sA, const void* B_, size_t sB, int nM_, int nN_, int nt_, int G_, int c_) { A = (const char*)A_; B = (const char*)B_; strideA = sA; strideB = sB; nM = nM_; nN = nN_; nwg = nM * nN; nt = nt_; G = G_; c = c_; }
    __device__ __forceinline__ bool next(int i, Unit& u) const {
        const int L = i * G + c; if (L >= nwg) return false;
        int wgid = L; { const int q = nwg / 8, r = nwg % 8, xcd = wgid % 8, off = wgid / 8; wgid = (xcd < r ? xcd * (q + 1) : r * (q + 1) + (xcd - r) * q) + off; }
        const int nig = 8 * nN, gid = wgid / nig, fm = gid * 8, gsz = (nM - fm) < 8 ? (nM - fm) : 8;
        u.pm = fm + ((wgid % nig) % gsz); { const int idx = (wgid % nig) / gsz; u.pn = idx < pn_s1 ? pn_a + idx : (idx < pn_s2 ? pn_b + idx - pn_s1 : pn_c + idx - pn_s2); }
        u.a = A + (size_t)u.pm * strideA; u.b = B + (size_t)u.pn * strideB; u.nt = nt; u.ks = -1; return true;
    }
};
struct SplitOrder {
    const char* A; const char* B; size_t strideA, strideB; int KT, G, c;
    __device__ __forceinline__ void init(const void* A_, size_t sA, const void* B_, size_t sB, int KT_, int G_, int c_) { A = (const char*)A_; B = (const char*)B_; strideA = sA; strideB = sB; KT = KT_; G = G_; c = c_; }
    __device__ __forceinline__ bool next(int i, Unit& u) const {
        const int L = i * G + c; if (L >= 512) return false;
        if (L < 256) { const int wgid = (L % 8) * 32 + L / 8;
            const int gid = wgid / 64, w = wgid % 64; u.pm = gid * 8 + (w % 8); u.pn = w / 8; u.nt = KT; u.ks = -1;
            u.a = A + (size_t)u.pm * strideA; u.b = B + (size_t)u.pn * strideB; return true; }
        const int sidx = L - 256, su = sidx >> 3, ks = sidx & 7; u.pm = 32 + (su & 3); u.pn = su >> 2; u.ks = ks;
        int kt0; if (KT == 88) { u.nt = (ks & 1) ? 10 : 12; kt0 = (ks >> 1) * 22 + (ks & 1) * 12; } else if (KT == 44) { u.nt = ks < 6 ? 6 : 4; kt0 = ks < 6 ? ks * 6 : 36 + (ks - 6) * 4; } else { u.nt = KT / 8; kt0 = ks * u.nt; }
        u.a = A + (size_t)u.pm * strideA + (size_t)kt0 * 128; u.b = B + (size_t)u.pn * strideB + (size_t)kt0 * 128; return true;
    }
};
}
using pg8::Unit;

#define EPI_ARGS const f32x4 (&acc)[2][2][4][2], const Unit& u, int wr, int wc, int fr, int fq
#define EPI_OPAQUE() asm volatile("" : "+v"(fr), "+v"(fq))
#define FOR_AI_M _Pragma("unroll") for (int ai = 0; ai < 2; ++ai) _Pragma("unroll") for (int m = 0; m < 4; ++m) if ((__builtin_amdgcn_sched_barrier(0), true))

#define FOR_AI_M_FREE _Pragma("unroll") for (int ai = 0; ai < 2; ++ai) _Pragma("unroll") for (int m = 0; m < 4; ++m)
struct EpiSwiglu {
    bf16* H;
    __device__ __forceinline__ void operator()(EPI_ARGS) const { EPI_OPAQUE();
        const int col0 = u.pn * 128 + wc * 32 + 8 * fq;
        FOR_AI_M { const int row = u.pm * 256 + ai * 128 + wr * 64 + m * 16 + fr;
            float o[8];
#pragma unroll
            for (int n = 0; n < 2; ++n)
#pragma unroll
                for (int j = 0; j < 4; ++j) o[4 * n + j] = siluf_(acc[ai][0][m][n][j]) * acc[ai][1][m][n][j];
            u32x4 w; w.x = cvt_pk_bf16(o[0], o[1]); w.y = cvt_pk_bf16(o[2], o[3]); w.z = cvt_pk_bf16(o[4], o[5]); w.w = cvt_pk_bf16(o[6], o[7]);
            *(u32x4*)(H + (size_t)row * FF + col0) = w; }
    }
};
struct EpiSwigluQ8 {
    unsigned char* H; const float* rs; const unsigned* cm;
    __device__ __forceinline__ void operator()(EPI_ARGS) const { EPI_OPAQUE();
        const int col0 = u.pn * 128 + wc * 32 + 8 * fq;
        float sg[8], su[8];
#pragma unroll
        for (int e = 0; e < 8; ++e) { sg[e] = __uint_as_float(cm[u.pn * 256 + wc * 32 + 8 * fq + e]) * (1.0f / 127.0f); su[e] = __uint_as_float(cm[u.pn * 256 + 128 + wc * 32 + 8 * fq + e]) * (1.0f / 127.0f); }
        float sav[2][4];
#pragma unroll
        for (int ai = 0; ai < 2; ++ai)
#pragma unroll
            for (int m = 0; m < 4; ++m) sav[ai][m] = rs[u.pm * 256 + ai * 128 + wr * 64 + m * 16 + fr];
        FOR_AI_M_FREE { const int row = u.pm * 256 + ai * 128 + wr * 64 + m * 16 + fr; const float sa = sav[ai][m];
            float o[8];
#pragma unroll
            for (int n = 0; n < 2; ++n)
#pragma unroll
                for (int j = 0; j < 4; ++j) { const float fg = acc[ai][0][m][n][j], fu = acc[ai][1][m][n][j];
                    const float g = (float)__float_as_int(fg) * (sa * sg[4 * n + j]), uu = (float)__float_as_int(fu) * (sa * su[4 * n + j]);
                    o[4 * n + j] = __builtin_amdgcn_fmed3f(siluf_(g) * uu * H8_SCALE, -440.0f, 440.0f); }
            u32x2 w; w.x = f2fp8x4(o[0], o[1], o[2], o[3]); w.y = f2fp8x4(o[4], o[5], o[6], o[7]);
            *(u32x2*)(H + (size_t)row * FF + col0) = w; }
    }
};
template <bool INBF> struct EpiResid {
    const void* inP; bf16* out; float alpha; float* slab; float accs;
    __device__ __forceinline__ void operator()(EPI_ARGS) const { EPI_OPAQUE();
        if (u.ks >= 0) {
            bf16* o = (bf16*)slab + ((size_t)u.ks * MS + (size_t)(u.pm - 32) * 256) * D;
            FOR_AI_M { const int rl = ai * 128 + wr * 64 + m * 16 + fr;
#pragma unroll
                for (int bj = 0; bj < 2; ++bj) { const size_t off = (size_t)rl * D + u.pn * 256 + bj * 128 + wc * 32 + 8 * fq; const f32x4 a0 = acc[ai][bj][m][0] * accs, a1 = acc[ai][bj][m][1] * accs;
                    u32x4 w; w.x = cvt_pk_bf16(a0[0], a0[1]); w.y = cvt_pk_bf16(a0[2], a0[3]); w.z = cvt_pk_bf16(a1[0], a1[1]); w.w = cvt_pk_bf16(a1[2], a1[3]); *(u32x4*)(o + off) = w; } }
            return; }
        bf16* o = out + (size_t)u.pm * 256 * D;
        FOR_AI_M { const int rl = ai * 128 + wr * 64 + m * 16 + fr;
#pragma unroll
            for (int bj = 0; bj < 2; ++bj) { const size_t off = (size_t)rl * D + u.pn * 256 + bj * 128 + wc * 32 + 8 * fq; f32x4 x0, x1;
                if (INBF) { const u32x4 xw = *(const u32x4*)((const bf16*)inP + (size_t)u.pm * 256 * D + off); x0 = (f32x4){bflo(xw.x), bfhi(xw.x), bflo(xw.y), bfhi(xw.y)}; x1 = (f32x4){bflo(xw.z), bfhi(xw.z), bflo(xw.w), bfhi(xw.w)}; }
                else { const float* in = (const float*)inP + (size_t)u.pm * 256 * D + off; x0 = *(const f32x4*)in; x1 = *(const f32x4*)(in + 4); }
                const f32x4 r0 = x0 + alpha * acc[ai][bj][m][0], r1 = x1 + alpha * acc[ai][bj][m][1];
                u32x4 w; w.x = cvt_pk_bf16(r0[0], r0[1]); w.y = cvt_pk_bf16(r0[2], r0[3]); w.z = cvt_pk_bf16(r1[0], r1[1]); w.w = cvt_pk_bf16(r1[2], r1[3]); *(u32x4*)(o + off) = w; } }
    }
};
#define MIXV(ai, bj, m, n, j) (Q8 ? fmaf((float)__float_as_int(acc[ai][bj][m][n][j]), sa * sw[bj][n][j], bv[bj][n][j]) : acc[ai][bj][m][n][j] + bv[bj][n][j])
template <bool Q8> struct EpiMix {
    const float* bias; const float* cosT; const float* sinT;
    bf16 *XA, *GA, *Q, *K, *ACAT, *BCAT, *KTD, *VTS, *SG, *SA, *SB; LAS unsigned char* xl; const float* rs; const unsigned* cm;
    template <int ACT> __device__ __forceinline__ void plain_bf16(EPI_ARGS, bf16* O, int ldo, int ct) const {
        f32x4 bv[2][2], sw[2][2];
#pragma unroll
        for (int bj = 0; bj < 2; ++bj)
#pragma unroll
            for (int n = 0; n < 2; ++n) { bv[bj][n] = *(const f32x4*)(bias + u.pn * 256 + bj * 128 + wc * 32 + 8 * fq + 4 * n); if (Q8) { const u32x4 cw = *(const u32x4*)(cm + u.pn * 256 + bj * 128 + wc * 32 + 8 * fq + 4 * n); sw[bj][n] = (f32x4){__uint_as_float(cw.x), __uint_as_float(cw.y), __uint_as_float(cw.z), __uint_as_float(cw.w)} * (1.0f / 127.0f); } else sw[bj][n] = (f32x4){0.f, 0.f, 0.f, 0.f}; }
        float sav[2][4];
#pragma unroll
        for (int ai = 0; ai < 2; ++ai)
#pragma unroll
            for (int m = 0; m < 4; ++m) sav[ai][m] = Q8 ? rs[u.pm * 256 + ai * 128 + wr * 64 + m * 16 + fr] : 0.f;
        FOR_AI_M_FREE { const int row = u.pm * 256 + ai * 128 + wr * 64 + m * 16 + fr; const float sa = sav[ai][m];
#pragma unroll
            for (int bj = 0; bj < 2; ++bj) { float o[8];
#pragma unroll
                for (int n = 0; n < 2; ++n)
#pragma unroll
                    for (int j = 0; j < 4; ++j) { const float v = MIXV(ai, bj, m, n, j); o[4 * n + j] = ACT == 0 ? gelu_tanh_(v) : (ACT == 1 ? siluf_(v) : (ACT == 2 ? sigmoidf_(v) : v)); }
                u32x4 w; w.x = cvt_pk_bf16(o[0], o[1]); w.y = cvt_pk_bf16(o[2], o[3]); w.z = cvt_pk_bf16(o[4], o[5]); w.w = cvt_pk_bf16(o[6], o[7]);
                *(u32x4*)(O + (size_t)row * ldo + ct * 256 + bj * 128 + wc * 32 + 8 * fq) = w; } }
    }
    __device__ __forceinline__ void operator()(EPI_ARGS) const { EPI_OPAQUE();
        const int pn = u.pn;
        if (pn < 8) { plain_bf16<3>(acc, u, wr, wc, fr, fq, XA, D, pn);
        } else if (pn < 16) { plain_bf16<0>(acc, u, wr, wc, fr, fq, GA, D, pn - 8);
        } else if (pn < 32) {
            const bool isk = pn >= 24; const int hh = (pn - 16) & 7; const float l2g = log2gamma(hh);
            const bool prompt = u.pm < 32; const float ksc = isk ? 0.0625f : 1.0f;
            f32x4 bv[2][2], sw[2][2];
#pragma unroll
            for (int bj = 0; bj < 2; ++bj)
#pragma unroll
                for (int n = 0; n < 2; ++n) { bv[bj][n] = *(const f32x4*)(bias + pn * 256 + bj * 128 + wc * 32 + 8 * fq + 4 * n); if (Q8) { const u32x4 cw = *(const u32x4*)(cm + pn * 256 + bj * 128 + wc * 32 + 8 * fq + 4 * n); sw[bj][n] = (f32x4){__uint_as_float(cw.x), __uint_as_float(cw.y), __uint_as_float(cw.z), __uint_as_float(cw.w)} * (1.0f / 127.0f); } else sw[bj][n] = (f32x4){0.f, 0.f, 0.f, 0.f}; }
            bf16* QK = isk ? K : Q;
            float sav[2][4];
#pragma unroll
        for (int ai = 0; ai < 2; ++ai)
#pragma unroll
            for (int m = 0; m < 4; ++m) sav[ai][m] = Q8 ? rs[u.pm * 256 + ai * 128 + wr * 64 + m * 16 + fr] : 0.f;
            FOR_AI_M { const int rl = ai * 128 + wr * 64 + m * 16 + fr; const float sa = sav[ai][m];
                int tp; size_t rowbase;
                int bhc = 0;
                if (prompt) { const int b = u.pm >> 3, c = u.pm & 7; tp = c * 256 + rl; bhc = (b * 8 + hh) * 8 + c; rowbase = ((size_t)bhc * 256 + rl) * 256; }
                else { const int sr = (u.pm - 32) * 256 + rl, b = sr >> 3, t = sr & 7; tp = 2048 + t; rowbase = (size_t)32 * 2048 * 256 + ((size_t)(b * 8 + hh) * 8 + t) * 256; }
                float o1[8], o2[8];
#pragma unroll
                for (int n = 0; n < 2; ++n) { const f32x4 cv = *(const f32x4*)(cosT + (size_t)tp * 128 + wc * 32 + 8 * fq + 4 * n), sv = *(const f32x4*)(sinT + (size_t)tp * 128 + wc * 32 + 8 * fq + 4 * n);
#pragma unroll
                    for (int j = 0; j < 4; ++j) { const float x1 = MIXV(ai, 0, m, n, j), x2 = MIXV(ai, 1, m, n, j);
                        o1[4 * n + j] = (x1 * cv[j] - x2 * sv[j]) * ksc; o2[4 * n + j] = (x2 * cv[j] + x1 * sv[j]) * ksc; } }
                const int dk0 = wc * 32 + 8 * fq;
                u32x4 w1, w2; w1.x = cvt_pk_bf16(o1[0], o1[1]); w1.y = cvt_pk_bf16(o1[2], o1[3]); w1.z = cvt_pk_bf16(o1[4], o1[5]); w1.w = cvt_pk_bf16(o1[6], o1[7]);
                w2.x = cvt_pk_bf16(o2[0], o2[1]); w2.y = cvt_pk_bf16(o2[2], o2[3]); w2.z = cvt_pk_bf16(o2[4], o2[5]); w2.w = cvt_pk_bf16(o2[6], o2[7]);
                *(u32x4*)(QK + rowbase + dk0) = w1; *(u32x4*)(QK + rowbase + 128 + dk0) = w2;
                if (prompt) {
                    if (!isk) {
                        const float g = fast_exp2((float)(rl + 1) * l2g); bf16* p = ACAT + ((size_t)bhc * 256 + rl) * 512 + 256 + dk0;
                        u32x4 v1, v2; v1.x = cvt_pk_bf16(o1[0] * g, o1[1] * g); v1.y = cvt_pk_bf16(o1[2] * g, o1[3] * g); v1.z = cvt_pk_bf16(o1[4] * g, o1[5] * g); v1.w = cvt_pk_bf16(o1[6] * g, o1[7] * g);
                        v2.x = cvt_pk_bf16(o2[0] * g, o2[1] * g); v2.y = cvt_pk_bf16(o2[2] * g, o2[3] * g); v2.z = cvt_pk_bf16(o2[4] * g, o2[5] * g); v2.w = cvt_pk_bf16(o2[6] * g, o2[7] * g);
                        *(u32x4*)p = v1; *(u32x4*)(p + 128) = v2;
                    } else {
                        const float g = fast_exp2((float)(255 - rl) * l2g); LAS bf16* scr = (LAS bf16*)(xl + (wr * 4 + wc) * 1024); const int ln = fr + 16 * fq;
#pragma unroll
                        for (int hf = 0; hf < 2; ++hf) {
#pragma unroll
                            for (int e = 0; e < 8; ++e) scr[(8 * fq + e) * 16 + fr] = (bf16)f2bf((hf ? o2[e] : o1[e]) * g);
                            asm volatile("" ::: "memory");
                            const u32x4 w = *(const LAS u32x4*)(scr + (ln >> 1) * 16 + (ln & 1) * 8);
                            asm volatile("" ::: "memory");
                            *(u32x4*)(KTD + ((size_t)bhc * 256 + hf * 128 + wc * 32 + (ln >> 1)) * 256 + (rl - fr) + (ln & 1) * 8) = w; }
                    }
                }
            }
        } else if (pn < 48) {
            const int hh = (pn - 32) >> 1, half = (pn - 32) & 1; const bool prompt = u.pm < 32;
            f32x4 bv[2][2], sw[2][2];
#pragma unroll
            for (int bj = 0; bj < 2; ++bj)
#pragma unroll
                for (int n = 0; n < 2; ++n) { bv[bj][n] = *(const f32x4*)(bias + pn * 256 + bj * 128 + wc * 32 + 8 * fq + 4 * n); if (Q8) { const u32x4 cw = *(const u32x4*)(cm + pn * 256 + bj * 128 + wc * 32 + 8 * fq + 4 * n); sw[bj][n] = (f32x4){__uint_as_float(cw.x), __uint_as_float(cw.y), __uint_as_float(cw.z), __uint_as_float(cw.w)} * (1.0f / 127.0f); } else sw[bj][n] = (f32x4){0.f, 0.f, 0.f, 0.f}; }
            LAS bf16* scr = (LAS bf16*)(xl + (wr * 4 + wc) * 1024); const int ln = fr + 16 * fq;
            FOR_AI_M { const int rb = ai * 128 + wr * 64 + m * 16; const float sa = Q8 ? rs[u.pm * 256 + rb + fr] : 0.f;
                bf16* p; size_t es;
                if (prompt) { const int b = u.pm >> 3, c = u.pm & 7, bhc = (b * 8 + hh) * 8 + c; p = BCAT + (size_t)bhc * 512 * 512 + rb + (ln & 1) * 8; es = 512; }
                else { const int sr = (u.pm - 32) * 256 + rb, b = (sr >> 3) + (ln & 1); p = VTS + (size_t)(b * 8 + hh) * 512 * 8; es = 8; }
#pragma unroll
                for (int bj = 0; bj < 2; ++bj) {
#pragma unroll
                    for (int n = 0; n < 2; ++n)
#pragma unroll
                        for (int j = 0; j < 4; ++j) scr[(8 * fq + 4 * n + j) * 16 + fr] = (bf16)f2bf(MIXV(ai, bj, m, n, j));
                    asm volatile("" ::: "memory");
                    const u32x4 w = *(const LAS u32x4*)(scr + (ln >> 1) * 16 + (ln & 1) * 8);
                    asm volatile("" ::: "memory");
                    *(u32x4*)(p + (size_t)(half * 256 + bj * 128 + wc * 32 + (ln >> 1)) * es) = w; }
            }
        } else if (pn < 64) { plain_bf16<1>(acc, u, wr, wc, fr, fq, SG, VD, pn - 48);
        } else { plain_bf16<2>(acc, u, wr, wc, fr, fq, pn < 72 ? SA : SB, D, (pn - 64) & 7); }
    }
};
#undef MIXV
struct EpiLru {
    const bf16* XC; const float *ba, *bx, *lam; bf16 *AA, *BB;
    __device__ __forceinline__ void operator()(EPI_ARGS) const { EPI_OPAQUE();
        const int ch0 = (u.pn >> 1) * 256 + (u.pn & 1) * 128 + wc * 32 + 8 * fq;
        float vba[8], vbx[8], vsp[8];
#pragma unroll
        for (int e = 0; e < 8; ++e) { vba[e] = ba[ch0 + e]; vbx[e] = bx[ch0 + e]; vsp[e] = log1pf(expf(-lam[ch0 + e])); }
        FOR_AI_M_FREE { const int row = u.pm * 256 + ai * 128 + wr * 64 + m * 16 + fr;
            const bool first = (row < MP) && ((row & (TP - 1)) == 0);
            const u32x4 xw = *(const u32x4*)(XC + (size_t)row * D + ch0);
            const float xc[8] = {bflo(xw.x), bfhi(xw.x), bflo(xw.y), bfhi(xw.y), bflo(xw.z), bfhi(xw.z), bflo(xw.w), bfhi(xw.w)};
            float av[8], bvv[8];
#pragma unroll
            for (int n = 0; n < 2; ++n)
#pragma unroll
                for (int j = 0; j < 4; ++j) { const int e = 4 * n + j;
                    const float r = sigmoidf_(acc[ai][0][m][n][j] + vba[e]), gi = sigmoidf_(acc[ai][1][m][n][j] + vbx[e]);
                    const float la2 = -11.5415603271f * r * vsp[e];
                    const float a = fast_exp2(la2); float mult = __builtin_amdgcn_sqrtf(fmaxf(1.0f - a * a, 0.0f)); if (first) mult = 1.0f;
                    av[e] = 1.0f - a; bvv[e] = mult * gi * xc[e]; }
            u32x4 wa, wb; wa.x = cvt_pk_bf16(av[0], av[1]); wa.y = cvt_pk_bf16(av[2], av[3]); wa.z = cvt_pk_bf16(av[4], av[5]); wa.w = cvt_pk_bf16(av[6], av[7]);
            wb.x = cvt_pk_bf16(bvv[0], bvv[1]); wb.y = cvt_pk_bf16(bvv[2], bvv[3]); wb.z = cvt_pk_bf16(bvv[4], bvv[5]); wb.w = cvt_pk_bf16(bvv[6], bvv[7]);
            *(u32x4*)(AA + (size_t)row * D + ch0) = wa; *(u32x4*)(BB + (size_t)row * D + ch0) = wb; }
    }
};
struct EpiScores {
    bf16* ACAT;
    __device__ __forceinline__ void operator()(EPI_ARGS) const { EPI_OPAQUE();
        const int bhc = u.pm, hh = (bhc >> 3) & 7; const float l2g = log2gamma(hh);
        FOR_AI_M { const int i = ai * 128 + wr * 64 + m * 16 + fr;
#pragma unroll
            for (int bj = 0; bj < 2; ++bj) { const int j0 = bj * 128 + wc * 32 + 8 * fq; float o[8];
#pragma unroll
                for (int n = 0; n < 2; ++n)
#pragma unroll
                    for (int jj = 0; jj < 4; ++jj) { const float fd = (float)(i - (j0 + 4 * n + jj)); o[4 * n + jj] = acc[ai][bj][m][n][jj] * fast_exp2(fd * l2g - fmaxf(-fd, 0.0f) * 1000.0f); }
                u32x4 w; w.x = cvt_pk_bf16(o[0], o[1]); w.y = cvt_pk_bf16(o[2], o[3]); w.z = cvt_pk_bf16(o[4], o[5]); w.w = cvt_pk_bf16(o[6], o[7]);
                *(u32x4*)(ACAT + ((size_t)bhc * 256 + i) * 512 + j0) = w; }
            __builtin_amdgcn_sched_barrier(0); }
    }
};
struct EpiUT {
    bf16* UT;
    __device__ __forceinline__ void operator()(EPI_ARGS) const { EPI_OPAQUE();
        bf16* base = UT + ((size_t)u.pm * 512 + u.pn * 256) * 256;
        FOR_AI_M { const int rl = ai * 128 + wr * 64 + m * 16 + fr;
#pragma unroll
            for (int bj = 0; bj < 2; ++bj) { const f32x4 a0 = acc[ai][bj][m][0], a1 = acc[ai][bj][m][1];
                u32x4 w; w.x = cvt_pk_bf16(a0[0], a0[1]); w.y = cvt_pk_bf16(a0[2], a0[3]); w.z = cvt_pk_bf16(a1[0], a1[1]); w.w = cvt_pk_bf16(a1[2], a1[3]);
                *(u32x4*)(base + (size_t)rl * 256 + bj * 128 + wc * 32 + 8 * fq) = w; } }
    }
};
struct EpiO {
    bf16* OF;
    __device__ __forceinline__ void operator()(EPI_ARGS) const { EPI_OPAQUE();
        const int bhc = u.pm, b = bhc >> 6, hh = (bhc >> 3) & 7, c = bhc & 7;
        bf16* base = OF + ((size_t)b * TP + c * 256) * VD + hh * 512 + u.pn * 256;
        FOR_AI_M { const int rl = ai * 128 + wr * 64 + m * 16 + fr;
#pragma unroll
            for (int bj = 0; bj < 2; ++bj) { const f32x4 a0 = acc[ai][bj][m][0], a1 = acc[ai][bj][m][1];
                u32x4 w; w.x = cvt_pk_bf16(a0[0], a0[1]); w.y = cvt_pk_bf16(a0[2], a0[3]); w.z = cvt_pk_bf16(a1[0], a1[1]); w.w = cvt_pk_bf16(a1[2], a1[3]);
                *(u32x4*)(base + (size_t)rl * VD + bj * 128 + wc * 32 + 8 * fq) = w; } }
    }
};
__device__ __forceinline__ void slab_store(EPI_ARGS, float* slab, float accs = 1.0f) {
    bf16* o = (bf16*)slab + ((size_t)u.ks * MS + (size_t)(u.pm - 32) * 256) * D;
    FOR_AI_M { const int rl = ai * 128 + wr * 64 + m * 16 + fr;
#pragma unroll
        for (int bj = 0; bj < 2; ++bj) { const size_t off = (size_t)rl * D + u.pn * 256 + bj * 128 + wc * 32 + 8 * fq; const f32x4 a0 = acc[ai][bj][m][0] * accs, a1 = acc[ai][bj][m][1] * accs;
            u32x4 w; w.x = cvt_pk_bf16(a0[0], a0[1]); w.y = cvt_pk_bf16(a0[2], a0[3]); w.z = cvt_pk_bf16(a1[0], a1[1]); w.w = cvt_pk_bf16(a1[2], a1[3]); *(u32x4*)(o + off) = w; } }
}
template <int MODE> struct EpiGate {
    const bf16* G; bf16* T; bf16* O; float* slab; float accs;
    __device__ __forceinline__ void operator()(EPI_ARGS) const { EPI_OPAQUE();
        if (u.ks >= 0) { slab_store(acc, u, wr, wc, fr, fq, slab, accs); return; }
        FOR_AI_M_FREE { const int row = u.pm * 256 + ai * 128 + wr * 64 + m * 16 + fr;
#pragma unroll
            for (int bj = 0; bj < 2; ++bj) { const size_t off = (size_t)row * D + u.pn * 256 + bj * 128 + wc * 32 + 8 * fq;
                const u32x4 gw = *(const u32x4*)(G + off);
                const f32x4 g0 = (f32x4){bflo(gw.x), bfhi(gw.x), bflo(gw.y), bfhi(gw.y)} * accs, g1 = (f32x4){bflo(gw.z), bfhi(gw.z), bflo(gw.w), bfhi(gw.w)} * accs;
                if (MODE == 0) { const f32x4 p0 = g0 * acc[ai][bj][m][0], p1 = g1 * acc[ai][bj][m][1];
                    u32x4 w; w.x = cvt_pk_bf16(p0[0], p0[1]); w.y = cvt_pk_bf16(p0[2], p0[3]); w.z = cvt_pk_bf16(p1[0], p1[1]); w.w = cvt_pk_bf16(p1[2], p1[3]); *(u32x4*)(T + off) = w; }
                else { const u32x4 tw = *(const u32x4*)(T + off);
                    const f32x4 t0 = (f32x4){bflo(tw.x), bfhi(tw.x), bflo(tw.y), bfhi(tw.y)} + g0 * acc[ai][bj][m][0], t1 = (f32x4){bflo(tw.z), bfhi(tw.z), bflo(tw.w), bfhi(tw.w)} + g1 * acc[ai][bj][m][1];
                    u32x4 w; w.x = cvt_pk_bf16(t0[0], t0[1]); w.y = cvt_pk_bf16(t0[2], t0[3]); w.z = cvt_pk_bf16(t1[0], t1[1]); w.w = cvt_pk_bf16(t1[2], t1[3]);
                    *(u32x4*)(O + off) = w; } } }
    }
};
struct EpiStoreF32 {
    bf16* T;
    __device__ __forceinline__ void operator()(EPI_ARGS) const { EPI_OPAQUE();
        FOR_AI_M { const int row = u.pm * 256 + ai * 128 + wr * 64 + m * 16 + fr;
#pragma unroll
            for (int bj = 0; bj < 2; ++bj) { const f32x4 a0 = acc[ai][bj][m][0], a1 = acc[ai][bj][m][1];
                u32x4 w; w.x = cvt_pk_bf16(a0[0], a0[1]); w.y = cvt_pk_bf16(a0[2], a0[3]); w.z = cvt_pk_bf16(a1[0], a1[1]); w.w = cvt_pk_bf16(a1[2], a1[3]);
                *(u32x4*)(T + (size_t)row * D + u.pn * 256 + bj * 128 + wc * 32 + 8 * fq) = w; } }
    }
};
struct EpiPle {
    const float* bg; const bf16* T; bf16* X; float* slab; const float* rs; const unsigned* cm;
    __device__ __forceinline__ void operator()(EPI_ARGS) const { EPI_OPAQUE();
        f32x4 bv[2][2], sw[2][2];
#pragma unroll
        for (int bj = 0; bj < 2; ++bj)
#pragma unroll
            for (int n = 0; n < 2; ++n) { bv[bj][n] = *(const f32x4*)(bg + u.pn * 256 + bj * 128 + wc * 32 + 8 * fq + 4 * n); const u32x4 cw = *(const u32x4*)(cm + u.pn * 256 + bj * 128 + wc * 32 + 8 * fq + 4 * n);
                sw[bj][n] = (f32x4){__uint_as_float(cw.x), __uint_as_float(cw.y), __uint_as_float(cw.z), __uint_as_float(cw.w)} * (1.0f / 127.0f); }
        if (u.ks >= 0) {
            bf16* o = (bf16*)slab + ((size_t)u.ks * MS + (size_t)(u.pm - 32) * 256) * D;
            FOR_AI_M_FREE { const int rl = ai * 128 + wr * 64 + m * 16 + fr; const float sa = rs[u.pm * 256 + rl];
#pragma unroll
                for (int bj = 0; bj < 2; ++bj) { const size_t off = (size_t)rl * D + u.pn * 256 + bj * 128 + wc * 32 + 8 * fq; float p[8];
#pragma unroll
                    for (int n = 0; n < 2; ++n)
#pragma unroll
                        for (int j = 0; j < 4; ++j) p[4 * n + j] = (float)__float_as_int(acc[ai][bj][m][n][j]) * (sa * sw[bj][n][j]);
                    u32x4 w; w.x = cvt_pk_bf16(p[0], p[1]); w.y = cvt_pk_bf16(p[2], p[3]); w.z = cvt_pk_bf16(p[4], p[5]); w.w = cvt_pk_bf16(p[6], p[7]); *(u32x4*)(o + off) = w; } }
            return; }
        float sav[2][4];
#pragma unroll
        for (int ai = 0; ai < 2; ++ai)
#pragma unroll
            for (int m = 0; m < 4; ++m) sav[ai][m] = rs[u.pm * 256 + ai * 128 + wr * 64 + m * 16 + fr];
        FOR_AI_M_FREE { const int row = u.pm * 256 + ai * 128 + wr * 64 + m * 16 + fr; const float sa = sav[ai][m];
#pragma unroll
            for (int bj = 0; bj < 2; ++bj) { const size_t off = (size_t)row * D + u.pn * 256 + bj * 128 + wc * 32 + 8 * fq;
                const u32x4 tw = *(const u32x4*)(T + off), xw = *(const u32x4*)(X + off);
                const float t[8] = {bflo(tw.x), bfhi(tw.x), bflo(tw.y), bfhi(tw.y), bflo(tw.z), bfhi(tw.z), bflo(tw.w), bfhi(tw.w)}, x[8] = {bflo(xw.x), bfhi(xw.x), bflo(xw.y), bfhi(xw.y), bflo(xw.z), bfhi(xw.z), bflo(xw.w), bfhi(xw.w)};
                float o[8];
#pragma unroll
                for (int n = 0; n < 2; ++n)
#pragma unroll
                    for (int j = 0; j < 4; ++j) o[4 * n + j] = x[4 * n + j] + sigmoidf_(fmaf((float)__float_as_int(acc[ai][bj][m][n][j]), sa * sw[bj][n][j], bv[bj][n][j])) * t[4 * n + j];
                u32x4 w; w.x = cvt_pk_bf16(o[0], o[1]); w.y = cvt_pk_bf16(o[2], o[3]); w.z = cvt_pk_bf16(o[4], o[5]); w.w = cvt_pk_bf16(o[6], o[7]); *(u32x4*)(X + off) = w; } }
    }
};

struct OrderScores {
    const char* Q; const char* K; int G, c;
    __device__ __forceinline__ bool next(int i, Unit& u) const { const int L = i * G + c; if (L >= 256) return false; u.pm = L; u.pn = 0; u.nt = 4; u.ks = -1; u.a = Q + (size_t)L * 131072; u.b = K + (size_t)L * 131072; return true; }
};
struct OrderUT {
    const char* BC; const char* KT; int G, c;
    __device__ __forceinline__ bool next(int i, Unit& u) const { const int L = i * G + c; if (L >= 512) return false; u.pm = L & 255; u.pn = L >> 8;
        u.nt = 4; u.ks = -1; u.a = BC + ((size_t)u.pm * 512 + u.pn * 256) * 1024; u.b = KT + (size_t)u.pm * 131072; return true; }
};
struct OrderO {
    const char* AC; const char* BC; int G, c, v;
    __device__ __forceinline__ bool next(int i, Unit& u) const {
        int L;
        if (G == 256) {
            if (v < 128) { if (i > 0) return false; L = 128 + v; }
            else { if (i > 2) return false; const int li = v - 128; L = i == 0 ? li : (i == 1 ? li + 256 : 384 + li); } }
        else { L = i * G + c; if (L >= 512) return false; }
        u.pm = L & 255; u.pn = L >> 8;
        u.nt = 8; u.ks = -1; u.a = AC + (size_t)u.pm * 262144; u.b = BC + ((size_t)u.pm * 512 + u.pn * 256) * 1024; return true; }
};
struct OrderLru {
    const char* XC; const char* W; int G, c;
    __device__ __forceinline__ bool next(int i, Unit& u) const { const int L = i * G + c; if (L >= 576) return false; u.pm = L % 36; u.pn = L / 36;
        u.nt = 4; u.ks = -1; u.a = XC + ((size_t)u.pm * 256 * D + (u.pn >> 1) * 256) * 2; u.b = W + (size_t)u.pn * 131072; return true; }
};

#define XB_TMO      128
#define XB_XCNT(j)  (256  + 64 * (j))
#define XB_XSUB(j)  (1280 + 64 * (j))
#define XB_XGEN(j)  (2304 + 64 * (j))
#define XB_TOP      3328
#define XB_TOPGEN   3392
#define XCD_BAR_WORDS 3456
#define XB_SPIN_CAP (1u << 18)
__device__ __forceinline__ unsigned xb_ld(unsigned* p)              { return __hip_atomic_load(p, __ATOMIC_RELAXED, __HIP_MEMORY_SCOPE_AGENT); }
__device__ __forceinline__ unsigned xb_add(unsigned* p, unsigned v) { return __hip_atomic_fetch_add(p, v, __ATOMIC_RELAXED, __HIP_MEMORY_SCOPE_AGENT); }
__device__ __forceinline__ unsigned xb_xcc_id() { return (unsigned)__builtin_amdgcn_s_getreg((3 << 11) | 20) & 0xFu; }
#define XB_SPIN(cond, bar) do { unsigned _sp = 0; while (cond) { __builtin_amdgcn_s_sleep(1); \
    if ((++_sp & 255u) == 0u) { if (xb_ld(&(bar)[XB_TMO])) break; if (_sp > XB_SPIN_CAP) { atomicAdd(&(bar)[XB_TMO], 1u); break; } } } } while (0)
struct XcdBarrier { unsigned* bar; unsigned x; volatile LAS unsigned* st; };
__device__ __forceinline__ XcdBarrier xcd_barrier_post(unsigned* bar, volatile LAS unsigned* st) {
    XcdBarrier b; b.bar = bar; b.x = xb_xcc_id(); b.st = st;
    if (threadIdx.x == 0) (void)xb_add(&bar[XB_XCNT(b.x)], 1u);
    return b;
}
__device__ __forceinline__ void xcd_barrier_complete(unsigned* bar, unsigned x, unsigned& nloc, unsigned& nx) {
    const unsigned G = gridDim.x * gridDim.y * gridDim.z;
    unsigned sum, cnt, mine, sp = 0u;
    for (;;) {
        sum = 0u; cnt = 0u; mine = 0u;
#pragma unroll
        for (unsigned j = 0; j < 16; ++j) { const unsigned c = xb_ld(&bar[XB_XCNT(j)]); sum += c; cnt += (c > 0u) ? 1u : 0u; mine = (j == x) ? c : mine; }
        if (sum == G) break;
        __builtin_amdgcn_s_sleep(1);
        if ((++sp & 255u) == 0u) { if (xb_ld(&bar[XB_TMO])) break; if (sp > XB_SPIN_CAP) { atomicAdd(&bar[XB_TMO], 1u); break; } }
    }
    nloc = mine > 0u ? mine : 1u; nx = cnt > 0u ? cnt : 1u;
}
__device__ __forceinline__ void xcd_barrier(const XcdBarrier& b) {
    asm volatile("s_waitcnt vmcnt(0)" ::: "memory");
    __syncthreads();
    if (threadIdx.x == 0) {
        unsigned* bar = b.bar;
        __builtin_amdgcn_s_waitcnt(0);
        unsigned nloc = b.st[0], nx = b.st[1];
        if (nloc == 0u) { xcd_barrier_complete(bar, b.x, nloc, nx); b.st[0] = nloc; b.st[1] = nx; }
        const unsigned old = xb_add(&bar[XB_XSUB(b.x)], 1u);
        const unsigned gen = old / nloc;
        if (old + 1u == (gen + 1u) * nloc) {
            __builtin_amdgcn_fence(__ATOMIC_RELEASE, "agent");
            asm volatile("s_waitcnt vmcnt(0)" ::: "memory");
            const unsigned og = xb_add(&bar[XB_TOP], 1u);
            const unsigned tg = og / nx;
            if (og + 1u == (tg + 1u) * nx) xb_add(&bar[XB_TOPGEN], 1u);
            else XB_SPIN(xb_ld(&bar[XB_TOPGEN]) == tg, bar);
            __builtin_amdgcn_fence(__ATOMIC_ACQUIRE, "agent");
            xb_add(&bar[XB_XGEN(b.x)], 1u);
            asm volatile("s_waitcnt vmcnt(0)" ::: "memory");
        } else {
            XB_SPIN(xb_ld(&bar[XB_XGEN(b.x)]) == gen, bar);
            __builtin_amdgcn_fence(__ATOMIC_ACQUIRE, "agent");
            asm volatile("s_waitcnt vmcnt(0)" ::: "memory");
        }
    }
    __syncthreads();
}

struct TrItem { const float* W; bf16* WT; size_t drow0; int ldw, k0, n0, ldt; unsigned char* WT8; const unsigned* cm; };
__device__ __forceinline__ void tr_load(const TrItem& t, f32x4 (&v)[8], int lane) {
#pragma unroll
    for (int i = 0; i < 8; ++i) { const int kk = (lane >> 3) + 8 * i, c4 = lane & 7; v[i] = *(const f32x4*)(t.W + (size_t)(t.k0 + kk) * t.ldw + t.n0 + 4 * c4); }
}
__device__ __forceinline__ void tr_finish(const TrItem& t, const f32x4 (&v)[8], LAS float* scr, int lane) {
#pragma unroll
    for (int i = 0; i < 8; ++i) { const int kk = (lane >> 3) + 8 * i, c4 = lane & 7; LAS float* s = scr + kk * 33 + 4 * c4; s[0] = v[i][0]; s[1] = v[i][1]; s[2] = v[i][2]; s[3] = v[i][3]; }
    LDS_WAIT(); asm volatile("" ::: "memory");
    const int c = lane & 7;
#pragma unroll
    for (int j = 0; j < 4; ++j) { const int n = (lane >> 3) + 8 * j; const LAS float* s = scr + (8 * c) * 33 + n;
        if (t.WT8 && t.cm) { const float cmx = __uint_as_float(t.cm[t.drow0 + n]), qs = cmx > 0.f ? 127.0f / cmx : 0.f; u32x2 o8;
            o8.x = f2i8x4(s[0 * 33] * qs, s[1 * 33] * qs, s[2 * 33] * qs, s[3 * 33] * qs); o8.y = f2i8x4(s[4 * 33] * qs, s[5 * 33] * qs, s[6 * 33] * qs, s[7 * 33] * qs);
            *(u32x2*)(t.WT8 + (t.drow0 + n) * (size_t)t.ldt + t.k0 + 8 * c) = o8; }
        else if (t.WT8) { u32x2 o8; o8.x = f2fp8x4(s[0 * 33] * W8_SCALE, s[1 * 33] * W8_SCALE, s[2 * 33] * W8_SCALE, s[3 * 33] * W8_SCALE); o8.y = f2fp8x4(s[4 * 33] * W8_SCALE, s[5 * 33] * W8_SCALE, s[6 * 33] * W8_SCALE, s[7 * 33] * W8_SCALE);
            *(u32x2*)(t.WT8 + (t.drow0 + n) * (size_t)t.ldt + t.k0 + 8 * c) = o8; }
        else { u32x4 o; o.x = cvt_pk_bf16(s[0 * 33], s[1 * 33]); o.y = cvt_pk_bf16(s[2 * 33], s[3 * 33]); o.z = cvt_pk_bf16(s[4 * 33], s[5 * 33]); o.w = cvt_pk_bf16(s[6 * 33], s[7 * 33]);
            *(u32x4*)(t.WT + (t.drow0 + n) * (size_t)t.ldt + t.k0 + 8 * c) = o; } }
    LDS_WAIT(); asm volatile("" ::: "memory");
}
template <bool BF> __device__ __forceinline__ f32x4 ldrow4(const void* row, int i) { if (BF) { const u32x2 w = ((const u32x2*)row)[i]; return (f32x4){bflo(w.x), bfhi(w.x), bflo(w.y), bfhi(w.y)}; } else return ((const f32x4*)row)[i]; }
__device__ __forceinline__ void tr_absmax(const TrItem& t, const f32x4 (&v)[8], unsigned* cm, int lane) {
    f32x4 mx = {0.f, 0.f, 0.f, 0.f};
#pragma unroll
    for (int i = 0; i < 8; ++i)
#pragma unroll
        for (int e = 0; e < 4; ++e) mx[e] = fmaxf(mx[e], fabsf(v[i][e]));
#pragma unroll
    for (int e = 0; e < 4; ++e) { float m = mx[e]; m = fmaxf(m, __shfl_xor(m, 8)); m = fmaxf(m, __shfl_xor(m, 16)); m = fmaxf(m, __shfl_xor(m, 32)); mx[e] = m; }
    if (lane < 8) {
#pragma unroll
        for (int e = 0; e < 4; ++e) atomicMax(cm + t.drow0 + 4 * lane + e, __float_as_uint(mx[e])); }
}
template <bool INBF> __device__ __forceinline__ void rms_row_q8(const void* xrow, const float* gain, unsigned char* qrow, float* rs, int lane, bf16* orow = nullptr) {
    f32x4 v[8]; float s = 0.f;
#pragma unroll
    for (int j = 0; j < 8; ++j) { v[j] = ldrow4<INBF>(xrow, lane + 64 * j); s += (v[j][0] * v[j][0] + v[j][1] * v[j][1]) + (v[j][2] * v[j][2] + v[j][3] * v[j][3]); }
    const float rstd = 1.0f / sqrtf(wave_sum(s) * (1.0f / D) + EPS);
    float mx = 0.f;
#pragma unroll
    for (int j = 0; j < 8; ++j) { const f32x4 g = ((const f32x4*)gain)[lane + 64 * j]; v[j] = v[j] * rstd * g; mx = fmaxf(fmaxf(mx, fmaxf(fabsf(v[j][0]), fabsf(v[j][1]))), fmaxf(fabsf(v[j][2]), fabsf(v[j][3]))); }
    mx = wave_max(mx); const float qs = mx > 0.f ? 127.0f / mx : 0.f;
#pragma unroll
    for (int j = 0; j < 8; ++j) { ((unsigned*)qrow)[lane + 64 * j] = f2i8x4(v[j][0] * qs, v[j][1] * qs, v[j][2] * qs, v[j][3] * qs);
        if (orow) ((u32x2*)orow)[lane + 64 * j] = (u32x2){pk2(v[j][0], v[j][1]), pk2(v[j][2], v[j][3])}; }
    if (lane == 0) *rs = mx * (1.0f / 127.0f);
}
template <bool INBF> __device__ __forceinline__ void rms_row_bf16(const void* xrow, const float* gain, bf16* orow, int lane, unsigned char* o8row = nullptr) {
    f32x4 v[8]; float s = 0.f;
#pragma unroll
    for (int j = 0; j < 8; ++j) { v[j] = ldrow4<INBF>(xrow, lane + 64 * j); s += (v[j][0] * v[j][0] + v[j][1] * v[j][1]) + (v[j][2] * v[j][2] + v[j][3] * v[j][3]); }
    const float rstd = 1.0f / sqrtf(wave_sum(s) * (1.0f / D) + EPS);
    unsigned long long* o8 = (unsigned long long*)orow + lane;
#pragma unroll
    for (int j = 0; j < 8; ++j) { const f32x4 g = ((const f32x4*)gain)[lane + 64 * j];
        o8[64 * j] = (unsigned long long)pk2(v[j][0] * rstd * g[0], v[j][1] * rstd * g[1]) | ((unsigned long long)pk2(v[j][2] * rstd * g[2], v[j][3] * rstd * g[3]) << 32);
        if (o8row) ((unsigned*)o8row)[lane + 64 * j] = f2fp8x4(v[j][0] * rstd * g[0], v[j][1] * rstd * g[1], v[j][2] * rstd * g[2], v[j][3] * rstd * g[3]); }
}
template <bool INBF> __device__ __forceinline__ void rms_row_slab_bf16(const void* base, const float* slabrow, float alpha, bf16* xout, const float* gain, bf16* orow, int lane, unsigned char* o8row = nullptr) {
    f32x4 v[8]; float s = 0.f;
#pragma unroll
    for (int j = 0; j < 8; ++j) { f32x4 a = {0.f, 0.f, 0.f, 0.f};
#pragma unroll
        for (int k = 0; k < 8; ++k) { const u32x2 w = ((const u32x2*)((const bf16*)slabrow + (size_t)k * MS * D))[lane + 64 * j]; a += (f32x4){bflo(w.x), bfhi(w.x), bflo(w.y), bfhi(w.y)}; }
        v[j] = ldrow4<INBF>(base, lane + 64 * j) + alpha * a; ((u32x2*)xout)[lane + 64 * j] = (u32x2){cvt_pk_bf16(v[j][0], v[j][1]), cvt_pk_bf16(v[j][2], v[j][3])};
        s += (v[j][0] * v[j][0] + v[j][1] * v[j][1]) + (v[j][2] * v[j][2] + v[j][3] * v[j][3]); }
    const float rstd = 1.0f / sqrtf(wave_sum(s) * (1.0f / D) + EPS);
    unsigned long long* o8 = (unsigned long long*)orow + lane;
#pragma unroll
    for (int j = 0; j < 8; ++j) { const f32x4 g = ((const f32x4*)gain)[lane + 64 * j];
        o8[64 * j] = (unsigned long long)pk2(v[j][0] * rstd * g[0], v[j][1] * rstd * g[1]) | ((unsigned long long)pk2(v[j][2] * rstd * g[2], v[j][3] * rstd * g[3]) << 32);
        if (o8row) ((unsigned*)o8row)[lane + 64 * j] = f2fp8x4(v[j][0] * rstd * g[0], v[j][1] * rstd * g[1], v[j][2] * rstd * g[2], v[j][3] * rstd * g[3]); }
}
template <bool INBF> __device__ __forceinline__ void rms_row_slab_q8(const void* base, const float* slabrow, float alpha, bf16* xout, const float* gain, unsigned char* qrow, float* rs, int lane, bf16* orow = nullptr) {
    f32x4 v[8]; float s = 0.f;
#pragma unroll
    for (int j = 0; j < 8; ++j) { f32x4 a = {0.f, 0.f, 0.f, 0.f};
#pragma unroll
        for (int k = 0; k < 8; ++k) { const u32x2 w = ((const u32x2*)((const bf16*)slabrow + (size_t)k * MS * D))[lane + 64 * j]; a += (f32x4){bflo(w.x), bfhi(w.x), bflo(w.y), bfhi(w.y)}; }
        v[j] = ldrow4<INBF>(base, lane + 64 * j) + alpha * a; ((u32x2*)xout)[lane + 64 * j] = (u32x2){cvt_pk_bf16(v[j][0], v[j][1]), cvt_pk_bf16(v[j][2], v[j][3])};
        s += (v[j][0] * v[j][0] + v[j][1] * v[j][1]) + (v[j][2] * v[j][2] + v[j][3] * v[j][3]); }
    const float rstd = 1.0f / sqrtf(wave_sum(s) * (1.0f / D) + EPS);
    float mx = 0.f;
#pragma unroll
    for (int j = 0; j < 8; ++j) { const f32x4 g = ((const f32x4*)gain)[lane + 64 * j]; v[j] = v[j] * rstd * g; mx = fmaxf(fmaxf(mx, fmaxf(fabsf(v[j][0]), fabsf(v[j][1]))), fmaxf(fabsf(v[j][2]), fabsf(v[j][3]))); }
    mx = wave_max(mx); const float qs = mx > 0.f ? 127.0f / mx : 0.f;
#pragma unroll
    for (int j = 0; j < 8; ++j) { ((unsigned*)qrow)[lane + 64 * j] = f2i8x4(v[j][0] * qs, v[j][1] * qs, v[j][2] * qs, v[j][3] * qs);
        if (orow) ((u32x2*)orow)[lane + 64 * j] = (u32x2){pk2(v[j][0], v[j][1]), pk2(v[j][2], v[j][3])}; }
    if (lane == 0) *rs = mx * (1.0f / 127.0f);
}
__device__ __forceinline__ void rms_row_f32(const bf16* xrow, const float* gain, float* orow, int lane) {
    f32x4 v[8]; float s = 0.f;
#pragma unroll
    for (int j = 0; j < 8; ++j) { v[j] = ldrow4<true>(xrow, lane + 64 * j); s += (v[j][0] * v[j][0] + v[j][1] * v[j][1]) + (v[j][2] * v[j][2] + v[j][3] * v[j][3]); }
    const float rstd = 1.0f / sqrtf(wave_sum(s) * (1.0f / D) + EPS);
#pragma unroll
    for (int j = 0; j < 8; ++j) { const f32x4 g = ((const f32x4*)gain)[lane + 64 * j]; ((f32x4*)orow)[lane + 64 * j] = v[j] * rstd * g; }
}

__device__ __forceinline__ void rms_row_ple_f32(const bf16* xrow, const float* slabrow, const float* bg, const bf16* trow, const float* gain, float* orow, int lane) {
    f32x4 v[8]; float s = 0.f;
#pragma unroll
    for (int j = 0; j < 8; ++j) { f32x4 a = ((const f32x4*)bg)[lane + 64 * j];
#pragma unroll
        for (int k = 0; k < 8; ++k) { const u32x2 w = ((const u32x2*)((const bf16*)slabrow + (size_t)k * MS * D))[lane + 64 * j]; a += (f32x4){bflo(w.x), bfhi(w.x), bflo(w.y), bfhi(w.y)}; }
        const u32x2 tw = ((const u32x2*)trow)[lane + 64 * j]; const f32x4 t = {bflo(tw.x), bfhi(tw.x), bflo(tw.y), bfhi(tw.y)}, x = ldrow4<true>(xrow, lane + 64 * j);
#pragma unroll
        for (int e = 0; e < 4; ++e) v[j][e] = x[e] + sigmoidf_(a[e]) * t[e];
        s += (v[j][0] * v[j][0] + v[j][1] * v[j][1]) + (v[j][2] * v[j][2] + v[j][3] * v[j][3]); }
    const float rstd = 1.0f / sqrtf(wave_sum(s) * (1.0f / D) + EPS);
#pragma unroll
    for (int j = 0; j < 8; ++j) { const f32x4 g = ((const f32x4*)gain)[lane + 64 * j]; ((f32x4*)orow)[lane + 64 * j] = v[j] * rstd * g; }
}

struct Args { const float* in[34]; float* out; unsigned char* ws; int ph_lo, ph_hi; };
constexpr int NPHASE = 17;

__global__ void __launch_bounds__(NWAVES * 64, 2) mega_fwd(Args args) {
    extern __shared__ __attribute__((aligned(16))) unsigned char lds_raw[];
    LAS unsigned char* lds = (LAS unsigned char*)lds_raw;
    volatile LAS unsigned* MISC = (volatile LAS unsigned*)(lds + MISC_OFF);
    const int tid = threadIdx.x, lane = tid & 63, wave = __builtin_amdgcn_readfirstlane(tid >> 6);
    const int G = gridDim.x, bx = blockIdx.x;
    const int vcu = (G % 8 == 0) ? (bx % 8) * (G / 8) + bx / 8 : bx;
    const int gw = vcu * NWAVES + wave, NGW = G * NWAVES;
    const bool rb_ = (G == 256), ra_ = wave < 4; const int ria_ = vcu * 4 + (wave & 3);
    const int rnk_ = rb_ ? (ra_ ? 3 : 6) : (M + NGW - 1 - gw) / NGW;
#define ROWMAP(k) (rb_ ? (ra_ ? ((k) == 0 ? MP + ria_ : 2 * ria_ + (k) - 1) : 2048 + ria_ * 6 + (k)) : gw + (k) * NGW)
    const int gt = vcu * (NWAVES * 64) + tid, NGT = G * NWAVES * 64;
    unsigned char* ws = args.ws;
    gu32* ctl = (gu32*)(ws + WS_CTL);
    for (int w = tid; w < (LDS_BYTES - LDSCTL_OFF) / 4; w += NWAVES * 64) ((LAS unsigned*)(lds + LDSCTL_OFF))[w] = 0u;
    __syncthreads();
    XcdBarrier bar = xcd_barrier_post((unsigned*)(ctl + CW_BAR), MISC + 8);
    const int lo = args.ph_lo, hi = args.ph_hi;
#define IN(k) (lo <= (k) && (k) < hi)
#define SEAM(k) do { if (IN(k) && IN((k) + 1)) xcd_barrier(bar); } while (0)

#define x_prompt (args.in[0])
#define x_sample (args.in[1])
#define p_prompt (args.in[2])
#define p_sample (args.in[3])
#define state_lru (args.in[4])
#define state_conv (args.in[5])
#define state_ret (args.in[6])
#define ffn1_norm (args.in[7])
#define mix_norm (args.in[11])
#define b_in (args.in[13])
#define conv_w (args.in[14])
#define conv_b (args.in[15])
#define lru_ba (args.in[17])
#define lru_bx (args.in[19])
#define lru_lambda (args.in[20])
#define ret_norm (args.in[21])
#define ffn2_norm (args.in[25])
#define ple_norm (args.in[29])
#define ple_bg (args.in[31])
#define final_norm (args.in[33])
#define out (args.out)
#define W1A ((bf16*)(ws + WS_W1A))
#define W1D ((bf16*)(ws + WS_W1D))
#define W2A ((bf16*)(ws + WS_W2A))
#define W2D ((bf16*)(ws + WS_W2D))
#define WIN ((bf16*)(ws + WS_WIN))
#define WPA ((bf16*)(ws + WS_WPA))
#define WPB ((bf16*)(ws + WS_WPB))
#define WOUT ((bf16*)(ws + WS_WOUT))
#define WPG ((bf16*)(ws + WS_WPG))
#define WPP ((bf16*)(ws + WS_WPP))
#define WLRU ((bf16*)(ws + WS_WLRU))
#define COS ((float*)(ws + WS_COS))
#define SIN ((float*)(ws + WS_SIN))
#define U ((bf16*)(ws + WS_U))
#define HB ((bf16*)(ws + WS_HB))
#define X ((bf16*)(ws + WS_X))
#define XA ((bf16*)(ws + WS_XA))
#define SLAB ((float*)(ws + WS_XA))
#define GA ((bf16*)(ws + WS_GA))
#define Qb ((bf16*)(ws + WS_Q))
#define Kb ((bf16*)(ws + WS_K))
#define ACAT ((bf16*)(ws + WS_ACAT))
#define BCAT ((bf16*)(ws + WS_BCAT))
#define KTD ((bf16*)(ws + WS_KTD))
#define VTS ((bf16*)(ws + WS_VTS))
#define SG ((bf16*)(ws + WS_SG))
#define SA ((bf16*)(ws + WS_SA))
#define SB ((bf16*)(ws + WS_SB))
#define XC ((bf16*)(ws + WS_XC))
#define AA ((bf16*)(ws + WS_AA))
#define BB ((bf16*)(ws + WS_BB))
#define HL ((bf16*)(ws + WS_HL))
#define PC ((bf16*)(ws + WS_PC))
#define AGA ((float*)(ws + WS_AGA))
#define AGB ((float*)(ws + WS_AGB))
#define OA ((bf16*)(ws + WS_OA))
#define UT ((float*)(ws + WS_UT))
#define OF ((bf16*)(ws + WS_OF))
#define OB ((bf16*)(ws + WS_OB))
#define TMP ((float*)(ws + WS_TMP))
#define TMP2 ((float*)(ws + WS_TMP2))
#define MG ((bf16*)(ws + WS_MG))
#define PEB ((bf16*)(ws + WS_PE))
#define U8 ((unsigned char*)(ws + WS_U8))
#define WIN8 ((unsigned char*)(ws + WS_WIN8))
#define RS ((float*)(ws + WS_RS))
    LAS float* scr = (LAS float*)(lds + wave * 16384);
    constexpr int I_FA = 32 * 176, I_FD = 88 * 64, I_IN = 32 * 640, I_PA = 32 * 64, I_PB = 64 * 64, I_PP = 4 * 64, I_L = 4 * 8;
    constexpr int NITEMS = 6 * I_FA + I_IN + 3 * I_PA + I_PB + I_PP + 16 * I_L;
    static_assert(I_FA == I_FD, "ffn item counts");
    auto item = [&](int it) -> TrItem { TrItem t; t.WT8 = nullptr; t.cm = nullptr; int r = it;
        if (r < 6 * I_FA) { const int w = r / I_FA; r -= w * I_FA; const int f = w / 3, k = w % 3; t.W = args.in[(f ? 26 : 8) + k];
            if (k < 2) { const int kb = r / 176, nb = r % 176, n0 = nb * 32; t.ldw = FF; t.k0 = kb * 64; t.n0 = n0; t.WT = f ? W2A : W1A; t.drow0 = (size_t)(n0 >> 7) * 256 + k * 128 + (n0 & 127); t.ldt = D; t.WT8 = (unsigned char*)(f ? W2A : W1A); t.cm = (const unsigned*)(ctl + (f ? CW_CM2 : CW_CM1)); }
            else { const int kb = r / 64, nb = r % 64; t.ldw = D; t.k0 = kb * 64; t.n0 = nb * 32; t.WT = f ? W2D : W1D; t.drow0 = (size_t)nb * 32; t.ldt = FF; t.WT8 = (unsigned char*)(f ? W2D : W1D); }
            return t; }
        r -= 6 * I_FA;
        if (r < I_IN) { const int kb = r / 640, nb = r % 640; t.W = args.in[12]; t.ldw = NIN; t.k0 = kb * 64; t.n0 = nb * 32; t.WT = WIN; t.drow0 = (size_t)nb * 32; t.ldt = D; { const int ct = nb >> 3; if ((ct >= 8 && ct < 24) || ct >= 48) { t.WT8 = WIN8; t.cm = (const unsigned*)(ctl + CW_CM3); } } return t; } r -= I_IN;
        if (r < I_PA) { const int kb = r / 64, nb = r % 64; t.W = args.in[22]; t.ldw = D; t.k0 = kb * 64; t.n0 = nb * 32; t.WT = WPA; t.drow0 = (size_t)nb * 32; t.ldt = D; return t; } r -= I_PA;
        if (r < I_PB) { const int kb = r / 64, nb = r % 64; t.W = args.in[23]; t.ldw = D; t.k0 = kb * 64; t.n0 = nb * 32; t.WT = WPB; t.drow0 = (size_t)nb * 32; t.ldt = VD; t.WT8 = (unsigned char*)WPB; return t; } r -= I_PB;
        if (r < I_PA) { const int kb = r / 64, nb = r % 64; t.W = args.in[24]; t.ldw = D; t.k0 = kb * 64; t.n0 = nb * 32; t.WT = WOUT; t.drow0 = (size_t)nb * 32; t.ldt = D; return t; } r -= I_PA;
        if (r < I_PA) { const int kb = r / 64, nb = r % 64; t.W = args.in[30]; t.ldw = D; t.k0 = kb * 64; t.n0 = nb * 32; t.WT = WPG; t.drow0 = (size_t)nb * 32; t.ldt = D; t.WT8 = (unsigned char*)WPG; t.cm = (const unsigned*)(ctl + CW_CM4); return t; } r -= I_PA;
        if (r < I_PP) { const int kb = r / 64, nb = r % 64; t.W = args.in[32]; t.ldw = D; t.k0 = kb * 64; t.n0 = nb * 32; t.WT = WPP; t.drow0 = (size_t)nb * 32; t.ldt = PLE; return t; } r -= I_PP;
        { const int mat = r / I_L, q = r % I_L, which = mat >> 3, blk = mat & 7, kb = q / 8, nb = q % 8, n0 = nb * 32;
          t.W = args.in[which ? 18 : 16] + (size_t)blk * 65536; t.ldw = 256; t.k0 = kb * 64; t.n0 = n0; t.WT = WLRU; t.drow0 = (size_t)(2 * blk + (n0 >> 7)) * 256 + which * 128 + (n0 & 127); t.ldt = 256; return t; } };
    constexpr int R_W1A0 = 0, R_W1D0 = 2 * I_FA, R_W2A0 = 3 * I_FA, R_W2D0 = 5 * I_FA, R_WIN0 = 6 * I_FA, R_PA0 = R_WIN0 + I_IN, R_PB0 = R_PA0 + I_PA, R_WOUT0 = R_PB0 + I_PB, R_WPG0 = R_WOUT0 + I_PA, R_WPP0 = R_WPG0 + I_PA, R_LRU0 = R_WPP0 + I_PP;
    static_assert(R_LRU0 + 16 * I_L == NITEMS, "item ranges");
    auto convert = [&](int lo, int hi, int wk, int nwk) {
        f32x4 va[8], vb[8]; int it = lo + wk; TrItem ta, tb;
        if (it < hi) { ta = item(it); tr_load(ta, va, lane); }
        while (it < hi) {
            const int itb = it + nwk, itc = it + 2 * nwk;
            if (itb < hi) { tb = item(itb); tr_load(tb, vb, lane); }
            tr_finish(ta, va, scr, lane);
            if (itc < hi) { ta = item(itc); tr_load(ta, va, lane); }
            if (itb < hi) tr_finish(tb, vb, scr, lane);
            it = itc; } };
    auto absmax = [&](int lo, int hi, int wk, int nwk, unsigned* cm) {
        f32x4 va[8], vb[8]; int it = lo + wk; TrItem ta, tb;
        bool ha = false, hb = false;
        if (it < hi) { ta = item(it); ha = ta.cm != nullptr; if (ha) tr_load(ta, va, lane); }
        while (it < hi) {
            const int itb = it + nwk, itc = it + 2 * nwk;
            hb = false; if (itb < hi) { tb = item(itb); hb = tb.cm != nullptr; if (hb) tr_load(tb, vb, lane); }
            if (ha) tr_absmax(ta, va, cm, lane);
            ha = false; if (itc < hi) { ta = item(itc); ha = ta.cm != nullptr; if (ha) tr_load(ta, va, lane); }
            if (hb) tr_absmax(tb, vb, cm, lane);
            it = itc; } };
    if (IN(0)) {
        absmax(R_W1A0, R_W1D0, gw, NGW, (unsigned*)(ctl + CW_CM1));
        convert(R_W1D0, R_W1D0 + I_FA, gw, NGW);
        absmax(R_WIN0, R_WIN0 + I_IN, gw, NGW, (unsigned*)(ctl + CW_CM3));
        for (int i = gt; i < 2056 * 128; i += NGT) { const int tp = i >> 7, f = i & 127; const int pos = tp < 2048 ? tp : 16384 + (tp - 2048);
            const float inv = exp2f(-(float)f * (13.287712379549449f / 128.0f)); const float ang = (float)pos * inv; COS[i] = cosf(ang); SIN[i] = sinf(ang); }
        for (int i = gt; i < M * PLE / 4; i += NGT) { const int row = i >> 6, c4 = i & 63;
            const f32x4 v = (row < MP) ? ((const f32x4*)p_prompt)[(size_t)row * 64 + c4] : ((const f32x4*)p_sample)[(size_t)(row - MP) * 64 + c4];
            ((u32x2*)PEB)[i] = (u32x2){pk2(v[0], v[1]), pk2(v[2], v[3])}; }
        for (int m = gw; m < M; m += NGW) rms_row_q8<false>(m < MP ? x_prompt + (size_t)m * D : x_sample + (size_t)(m - MP) * D, ffn1_norm, U8 + (size_t)m * D, RS + m, lane);
        __syncthreads();
        xcd_barrier(bar);
        convert(R_W1A0, R_W1D0, gw, NGW);
        __syncthreads();
    }
    SEAM(0);
    if (IN(1)) { pg8::TileOrder S; S.init(U8, (size_t)256 * D, W1A, (size_t)256 * D, 36, 44, D / 128, G, bx); EpiSwigluQ8 E{(unsigned char*)HB, RS, (const unsigned*)(ctl + CW_CM1)};
        pg8::gemm_phase<EpiSwigluQ8, pg8::TileOrder, 2>(lds, D / 2, D / 2, S, E);
        if (bx >= 1584 - 6 * 256) convert(R_WIN0, R_WIN0 + I_IN, (bx - (1584 - 6 * 256)) * NWAVES + wave, (G - (1584 - 6 * 256)) * NWAVES); }
    SEAM(1);
    if (IN(2)) { pg8::SplitOrder S; S.init(HB, (size_t)256 * FF, W1D, (size_t)256 * FF, FF / 128, G, bx); EpiResid<false> E{x_prompt, X, 0.5f / (H8_SCALE * W8_SCALE), SLAB, 1.0f / (H8_SCALE * W8_SCALE)};
        pg8::gemm_phase<EpiResid<false>, pg8::SplitOrder, 1>(lds, FF / 2, FF / 2, S, E); }
    SEAM(2);
    if (IN(3)) { for (int k_ = 0; k_ < rnk_; ++k_) { const int m = ROWMAP(k_); if (m < MP) rms_row_q8<true>(X + (size_t)m * D, mix_norm, U8 + (size_t)m * D, RS + m, lane, U + (size_t)m * D);
            else rms_row_slab_q8<false>(x_sample + (size_t)(m - MP) * D, (const float*)((const bf16*)SLAB + (size_t)(m - MP) * D), 0.5f, X + (size_t)m * D, mix_norm, U8 + (size_t)m * D, RS + m, lane, U + (size_t)m * D); } }
    SEAM(3);
    if (IN(4)) {
        { pg8::TileOrder S; S.init(U8, (size_t)256 * D, WIN8, (size_t)256 * D, 36, 48, D / 128, G, bx); S.pn_s1 = 16; S.pn_a = 8; S.pn_b = 48;
          EpiMix<true> E{b_in, COS, SIN, XA, GA, Qb, Kb, ACAT, BCAT, KTD, VTS, SG, SA, SB, lds + XPOSE_OFF, RS, (const unsigned*)(ctl + CW_CM3)};
          pg8::gemm_phase<EpiMix<true>, pg8::TileOrder, 2>(lds, D / 2, D / 2, S, E); }
        { pg8::TileOrder S; S.init(U, (size_t)256 * D * 2, WIN, (size_t)256 * D * 2, 36, 32, D / 64, G, (bx + G - 1728 % G) % G); S.pn_s1 = 8; S.pn_s2 = 16; S.pn_a = 0; S.pn_b = 24; S.pn_c = 32;
          EpiMix<false> E{b_in, COS, SIN, XA, GA, Qb, Kb, ACAT, BCAT, KTD, VTS, SG, SA, SB, lds + XPOSE_OFF, RS, (const unsigned*)(ctl + CW_CM3)};
          pg8::gemm_phase<EpiMix<false>, pg8::TileOrder, 0>(lds, D, D, S, E); }
        { const int c2 = (bx + G - 1728 % G) % G, nlast = G / 2;
          if (c2 >= nlast) { const int wk = (c2 - nlast) * NWAVES + wave, nwk = (G - nlast) * NWAVES;
            convert(R_LRU0, NITEMS, wk, nwk); convert(R_PA0, R_WPG0, wk, nwk); absmax(R_W2A0, R_W2D0, wk, nwk, (unsigned*)(ctl + CW_CM2)); absmax(R_WPG0, R_WPP0, wk, nwk, (unsigned*)(ctl + CW_CM4)); } }
    }
    SEAM(4);
    if (IN(5)) {
        if (bx & 1) {
        {
            LAS float* tab = (LAS float*)lds;
            LAS float* red = (LAS float*)(lds + 16384);
            LAS float* scs = (LAS float*)(lds + 16384 + 65536);
            for (int un = vcu; un < NBS * NH; un += G) {
                const int b = un >> 3, hh = un & 7; const float l2g = log2gamma(hh);
                const bf16* q = Qb + (size_t)32 * 2048 * 256 + (size_t)un * 2048; const bf16* k = Kb + (size_t)32 * 2048 * 256 + (size_t)un * 2048; const bf16* vt = VTS + (size_t)un * 4096;
                const float* S0 = state_ret + (size_t)un * 131072; float* Sn = out + O_RETS + (size_t)un * 131072;
                { const int dk = tid >> 1, which = tid & 1; const bf16* src = which ? k : q;
#pragma unroll
                  for (int i = 0; i < 8; ++i) tab[dk * 16 + which * 8 + i] = bf1(src[i * 256 + dk]) * fast_exp2((float)(which ? 7 - i : i + 1) * l2g); }
                { const int i = wave;
                  const u32x2 qw = ((const u32x2*)(q + i * 256))[lane]; const float q0 = bflo(qw.x), q1 = bfhi(qw.x), q2 = bflo(qw.y), q3 = bfhi(qw.y);
                  for (int j = 0; j < 8; ++j) { const u32x2 kw = ((const u32x2*)(k + j * 256))[lane];
                      float d = q0 * bflo(kw.x) + q1 * bfhi(kw.x) + q2 * bflo(kw.y) + q3 * bfhi(kw.y); d = wave_sum(d);
                      if (lane == 0) scs[i * 8 + j] = (j <= i) ? d * fast_exp2((float)(i - j) * l2g) : 0.0f; } }
                __syncthreads();
                const int dkq = tid >> 7, dv4 = tid & 127;
                float vv[4][8];
#pragma unroll
                for (int e = 0; e < 4; ++e) { const u32x4 w = *(const u32x4*)(vt + (size_t)(4 * dv4 + e) * 8);
                    vv[e][0] = bflo(w.x); vv[e][1] = bfhi(w.x); vv[e][2] = bflo(w.y); vv[e][3] = bfhi(w.y); vv[e][4] = bflo(w.z); vv[e][5] = bfhi(w.z); vv[e][6] = bflo(w.w); vv[e][7] = bfhi(w.w); }
                f32x4 cross[8];
#pragma unroll
                for (int i = 0; i < 8; ++i) cross[i] = (f32x4){0.f, 0.f, 0.f, 0.f};
                const float g8 = fast_exp2(8.0f * l2g);
                for (int it0 = 0; it0 < 64; it0 += 16) {
                    f32x4 sv[16];
#pragma unroll
                    for (int q2 = 0; q2 < 16; ++q2) sv[q2] = __builtin_nontemporal_load((const f32x4*)(S0 + (size_t)(4 * (it0 + q2) + dkq) * 512) + dv4);
#pragma unroll
                    for (int q2 = 0; q2 < 16; ++q2) { const int dk = 4 * (it0 + q2) + dkq; const f32x4 s = sv[q2];
                        const LAS f32x4* tq = (const LAS f32x4*)(tab + dk * 16); const f32x4 qa = tq[0], qb = tq[1], ka = tq[2], kb = tq[3];
                        cross[0] += qa[0] * s; cross[1] += qa[1] * s; cross[2] += qa[2] * s; cross[3] += qa[3] * s; cross[4] += qb[0] * s; cross[5] += qb[1] * s; cross[6] += qb[2] * s; cross[7] += qb[3] * s;
                        f32x4 sn = g8 * s;
#pragma unroll
                        for (int e = 0; e < 4; ++e) sn[e] += ka[0] * vv[e][0] + ka[1] * vv[e][1] + ka[2] * vv[e][2] + ka[3] * vv[e][3] + kb[0] * vv[e][4] + kb[1] * vv[e][5] + kb[2] * vv[e][6] + kb[3] * vv[e][7];
                        __builtin_nontemporal_store(sn, (f32x4*)(Sn + (size_t)dk * 512) + dv4); } }
#pragma unroll
                for (int i = 0; i < 8; ++i) *(LAS f32x4*)(red + ((dkq * 8 + i) * 512 + 4 * dv4)) = cross[i];
                __syncthreads();
                { const int dv = tid; const u32x4 w = *(const u32x4*)(vt + (size_t)dv * 8);
                  const float v[8] = {bflo(w.x), bfhi(w.x), bflo(w.y), bfhi(w.y), bflo(w.z), bfhi(w.z), bflo(w.w), bfhi(w.w)};
                  float o[8];
#pragma unroll
                  for (int i = 0; i < 8; ++i) { float a = (red[(0 * 8 + i) * 512 + dv] + red[(1 * 8 + i) * 512 + dv]) + (red[(2 * 8 + i) * 512 + dv] + red[(3 * 8 + i) * 512 + dv]);
#pragma unroll
                      for (int j = 0; j < 8; ++j) a += scs[i * 8 + j] * v[j];
                      o[i] = a; const float ss = wave_sum(a * a); if (lane == 0) scs[64 + wave * 8 + i] = ss; }
                  __syncthreads();
                  const float gn = ret_norm[hh * 512 + dv];
#pragma unroll
                  for (int i = 0; i < 8; ++i) { float tot = 0.f;
#pragma unroll
                      for (int w8 = 0; w8 < 8; ++w8) tot += scs[64 + w8 * 8 + i];
                      const float rstd = 1.0f / sqrtf(tot * (1.0f / 512.0f) + EPS); const size_t off = (size_t)(MP + b * 8 + i) * VD + hh * 512 + dv;
                      ((unsigned char*)OB)[off] = (unsigned char)(f2fp8x4(__builtin_amdgcn_fmed3f(o[i] * rstd * gn * bf1(SG[off]) * O8_SCALE, -440.0f, 440.0f), 0.f, 0.f, 0.f) & 255u); } }
                __syncthreads();
            }
        }
        for (int it = gt; it < (M / 8) * 512; it += NGT) { const int rc = it >> 9, c4 = it & 511, r0 = rc * 8;
            const f32x4 w0 = ((const f32x4*)conv_w)[c4], w1 = ((const f32x4*)conv_w)[512 + c4], w2 = ((const f32x4*)conv_w)[1024 + c4], w3 = ((const f32x4*)conv_w)[1536 + c4], cb = ((const f32x4*)conv_b)[c4];
            const u32x2* xa4 = (const u32x2*)XA + c4; f32x4 p0, p1, p2; const f32x4 z = {0.f, 0.f, 0.f, 0.f};
#define XA_ROW(r) ({ const u32x2 w_ = xa4[(size_t)(r) * 512]; (f32x4){bflo(w_.x), bfhi(w_.x), bflo(w_.y), bfhi(w_.y)}; })
            if (r0 < MP) { if ((r0 & (TP - 1)) == 0) { p0 = z; p1 = z; p2 = z; } else { p0 = XA_ROW(r0 - 3); p1 = XA_ROW(r0 - 2); p2 = XA_ROW(r0 - 1); } }
            else { const int b = (r0 - MP) >> 3; const f32x4* sc = (const f32x4*)state_conv + (size_t)b * 3 * 512 + c4; p0 = sc[0]; p1 = sc[512]; p2 = sc[1024]; }
            f32x4 cur[8];
#pragma unroll
            for (int t = 0; t < 8; ++t) cur[t] = XA_ROW(r0 + t);
#undef XA_ROW
#pragma unroll
            for (int t = 0; t < 8; ++t) { const f32x4 y = cb + w0 * p0 + w1 * p1 + w2 * p2 + w3 * cur[t];
                ((u32x2*)XC)[(size_t)(r0 + t) * 512 + c4] = (u32x2){pk2(y[0], y[1]), pk2(y[2], y[3])}; p0 = p1; p1 = p2; p2 = cur[t]; }
            if (r0 < MP) { if (((r0 + 8) & (TP - 1)) == 0) { const int b = r0 >> 11; f32x4* o = (f32x4*)(out + O_CONVP) + (size_t)b * 3 * 512 + c4; o[0] = cur[5]; o[512] = cur[6]; o[1024] = cur[7]; } }
            else { const int b = (r0 - MP) >> 3; f32x4* o = (f32x4*)(out + O_CONVS) + (size_t)b * 3 * 512 + c4; o[0] = cur[5]; o[512] = cur[6]; o[1024] = cur[7]; }
        }
        { OrderScores S{(const char*)Qb, (const char*)Kb, G, bx}; EpiScores E{ACAT}; pg8::gemm_phase(lds, 256, 256, S, E); }
        { OrderUT S{(const char*)BCAT, (const char*)KTD, G, bx}; EpiUT E{(bf16*)UT}; pg8::gemm_phase(lds, 512, 256, S, E); }
        } else {
        for (int it = gt; it < (M / 8) * 512; it += NGT) { const int rc = it >> 9, c4 = it & 511, r0 = rc * 8;
            const f32x4 w0 = ((const f32x4*)conv_w)[c4], w1 = ((const f32x4*)conv_w)[512 + c4], w2 = ((const f32x4*)conv_w)[1024 + c4], w3 = ((const f32x4*)conv_w)[1536 + c4], cb = ((const f32x4*)conv_b)[c4];
            const u32x2* xa4 = (const u32x2*)XA + c4; f32x4 p0, p1, p2; const f32x4 z = {0.f, 0.f, 0.f, 0.f};
#define XA_ROW(r) ({ const u32x2 w_ = xa4[(size_t)(r) * 512]; (f32x4){bflo(w_.x), bfhi(w_.x), bflo(w_.y), bfhi(w_.y)}; })
            if (r0 < MP) { if ((r0 & (TP - 1)) == 0) { p0 = z; p1 = z; p2 = z; } else { p0 = XA_ROW(r0 - 3); p1 = XA_ROW(r0 - 2); p2 = XA_ROW(r0 - 1); } }
            else { const int b = (r0 - MP) >> 3; const f32x4* sc = (const f32x4*)state_conv + (size_t)b * 3 * 512 + c4; p0 = sc[0]; p1 = sc[512]; p2 = sc[1024]; }
            f32x4 cur[8];
#pragma unroll
            for (int t = 0; t < 8; ++t) cur[t] = XA_ROW(r0 + t);
#undef XA_ROW
#pragma unroll
            for (int t = 0; t < 8; ++t) { const f32x4 y = cb + w0 * p0 + w1 * p1 + w2 * p2 + w3 * cur[t];
                ((u32x2*)XC)[(size_t)(r0 + t) * 512 + c4] = (u32x2){pk2(y[0], y[1]), pk2(y[2], y[3])}; p0 = p1; p1 = p2; p2 = cur[t]; }
            if (r0 < MP) { if (((r0 + 8) & (TP - 1)) == 0) { const int b = r0 >> 11; f32x4* o = (f32x4*)(out + O_CONVP) + (size_t)b * 3 * 512 + c4; o[0] = cur[5]; o[512] = cur[6]; o[1024] = cur[7]; } }
            else { const int b = (r0 - MP) >> 3; f32x4* o = (f32x4*)(out + O_CONVS) + (size_t)b * 3 * 512 + c4; o[0] = cur[5]; o[512] = cur[6]; o[1024] = cur[7]; }
        }
        { OrderScores S{(const char*)Qb, (const char*)Kb, G, bx}; EpiScores E{ACAT}; pg8::gemm_phase(lds, 256, 256, S, E); }
        { OrderUT S{(const char*)BCAT, (const char*)KTD, G, bx}; EpiUT E{(bf16*)UT}; pg8::gemm_phase(lds, 512, 256, S, E); }
        {
            LAS float* tab = (LAS float*)lds;
            LAS float* red = (LAS float*)(lds + 16384);
            LAS float* scs = (LAS float*)(lds + 16384 + 65536);
            for (int un = vcu; un < NBS * NH; un += G) {
                const int b = un >> 3, hh = un & 7; const float l2g = log2gamma(hh);
                const bf16* q = Qb + (size_t)32 * 2048 * 256 + (size_t)un * 2048; const bf16* k = Kb + (size_t)32 * 2048 * 256 + (size_t)un * 2048; const bf16* vt = VTS + (size_t)un * 4096;
                const float* S0 = state_ret + (size_t)un * 131072; float* Sn = out + O_RETS + (size_t)un * 131072;
                { const int dk = tid >> 1, which = tid & 1; const bf16* src = which ? k : q;
#pragma unroll
                  for (int i = 0; i < 8; ++i) tab[dk * 16 + which * 8 + i] = bf1(src[i * 256 + dk]) * fast_exp2((float)(which ? 7 - i : i + 1) * l2g); }
                { const int i = wave;
                  const u32x2 qw = ((const u32x2*)(q + i * 256))[lane]; const float q0 = bflo(qw.x), q1 = bfhi(qw.x), q2 = bflo(qw.y), q3 = bfhi(qw.y);
                  for (int j = 0; j < 8; ++j) { const u32x2 kw = ((const u32x2*)(k + j * 256))[lane];
                      float d = q0 * bflo(kw.x) + q1 * bfhi(kw.x) + q2 * bflo(kw.y) + q3 * bfhi(kw.y); d = wave_sum(d);
                      if (lane == 0) scs[i * 8 + j] = (j <= i) ? d * fast_exp2((float)(i - j) * l2g) : 0.0f; } }
                __syncthreads();
                const int dkq = tid >> 7, dv4 = tid & 127;
                float vv[4][8];
#pragma unroll
                for (int e = 0; e < 4; ++e) { const u32x4 w = *(const u32x4*)(vt + (size_t)(4 * dv4 + e) * 8);
                    vv[e][0] = bflo(w.x); vv[e][1] = bfhi(w.x); vv[e][2] = bflo(w.y); vv[e][3] = bfhi(w.y); vv[e][4] = bflo(w.z); vv[e][5] = bfhi(w.z); vv[e][6] = bflo(w.w); vv[e][7] = bfhi(w.w); }
                f32x4 cross[8];
#pragma unroll
                for (int i = 0; i < 8; ++i) cross[i] = (f32x4){0.f, 0.f, 0.f, 0.f};
                const float g8 = fast_exp2(8.0f * l2g);
                for (int it0 = 0; it0 < 64; it0 += 16) {
                    f32x4 sv[16];
#pragma unroll
                    for (int q2 = 0; q2 < 16; ++q2) sv[q2] = __builtin_nontemporal_load((const f32x4*)(S0 + (size_t)(4 * (it0 + q2) + dkq) * 512) + dv4);
#pragma unroll
                    for (int q2 = 0; q2 < 16; ++q2) { const int dk = 4 * (it0 + q2) + dkq; const f32x4 s = sv[q2];
                        const LAS f32x4* tq = (const LAS f32x4*)(tab + dk * 16); const f32x4 qa = tq[0], qb = tq[1], ka = tq[2], kb = tq[3];
                        cross[0] += qa[0] * s; cross[1] += qa[1] * s; cross[2] += qa[2] * s; cross[3] += qa[3] * s; cross[4] += qb[0] * s; cross[5] += qb[1] * s; cross[6] += qb[2] * s; cross[7] += qb[3] * s;
                        f32x4 sn = g8 * s;
#pragma unroll
                        for (int e = 0; e < 4; ++e) sn[e] += ka[0] * vv[e][0] + ka[1] * vv[e][1] + ka[2] * vv[e][2] + ka[3] * vv[e][3] + kb[0] * vv[e][4] + kb[1] * vv[e][5] + kb[2] * vv[e][6] + kb[3] * vv[e][7];
                        __builtin_nontemporal_store(sn, (f32x4*)(Sn + (size_t)dk * 512) + dv4); } }
#pragma unroll
                for (int i = 0; i < 8; ++i) *(LAS f32x4*)(red + ((dkq * 8 + i) * 512 + 4 * dv4)) = cross[i];
                __syncthreads();
                { const int dv = tid; const u32x4 w = *(const u32x4*)(vt + (size_t)dv * 8);
                  const float v[8] = {bflo(w.x), bfhi(w.x), bflo(w.y), bfhi(w.y), bflo(w.z), bfhi(w.z), bflo(w.w), bfhi(w.w)};
                  float o[8];
#pragma unroll
                  for (int i = 0; i < 8; ++i) { float a = (red[(0 * 8 + i) * 512 + dv] + red[(1 * 8 + i) * 512 + dv]) + (red[(2 * 8 + i) * 512 + dv] + red[(3 * 8 + i) * 512 + dv]);
#pragma unroll
                      for (int j = 0; j < 8; ++j) a += scs[i * 8 + j] * v[j];
                      o[i] = a; const float ss = wave_sum(a * a); if (lane == 0) scs[64 + wave * 8 + i] = ss; }
                  __syncthreads();
                  const float gn = ret_norm[hh * 512 + dv];
#pragma unroll
                  for (int i = 0; i < 8; ++i) { float tot = 0.f;
#pragma unroll
                      for (int w8 = 0; w8 < 8; ++w8) tot += scs[64 + w8 * 8 + i];
                      const float rstd = 1.0f / sqrtf(tot * (1.0f / 512.0f) + EPS); const size_t off = (size_t)(MP + b * 8 + i) * VD + hh * 512 + dv;
                      ((unsigned char*)OB)[off] = (unsigned char)(f2fp8x4(__builtin_amdgcn_fmed3f(o[i] * rstd * gn * bf1(SG[off]) * O8_SCALE, -440.0f, 440.0f), 0.f, 0.f, 0.f) & 255u); } }
                __syncthreads();
            }
        }
        }
    }
    SEAM(5);
    if (IN(6)) {
        { OrderLru S{(const char*)XC, (const char*)WLRU, G, bx}; EpiLru E{XC, lru_ba, lru_bx, lru_lambda, AA, BB}; pg8::gemm_phase(lds, D, 256, S, E); }
        if (bx >= 576 - 2 * G) convert(R_W2A0, R_W2D0, (bx - (576 - 2 * G)) * NWAVES + wave, (G - (576 - 2 * G)) * NWAVES);
        for (int wt = gw; wt < 32 * 32 * 16; wt += NGW) { const int bh = wt >> 9, dvb = (wt >> 4) & 31, dkb = wt & 15;
            const int dv = dvb * 16 + (lane & 15), dk0 = dkb * 16 + (lane >> 4) * 4; const float g256 = fast_exp2(256.0f * log2gamma(bh & 7));
            f32x4 Sv = {0.f, 0.f, 0.f, 0.f}, uu[8];
#pragma unroll
            for (int c = 0; c < 8; ++c) { const u32x2 w = *(const u32x2*)((const bf16*)UT + (((size_t)bh * 8 + c) * 512 + dv) * 256 + dk0); uu[c] = (f32x4){bflo(w.x), bfhi(w.x), bflo(w.y), bfhi(w.y)}; }
#pragma unroll
            for (int c = 0; c < 8; ++c) { const size_t bhc = (size_t)bh * 8 + c;
                *(u32x2*)(BCAT + (bhc * 512 + dv) * 512 + 256 + dk0) = (u32x2){pk2(Sv[0], Sv[1]), pk2(Sv[2], Sv[3])};
                Sv = g256 * Sv + uu[c]; }
            float* o = out + O_RETP + ((size_t)bh * 256 + dk0) * 512 + dv;
            o[0] = Sv[0]; o[512] = Sv[1]; o[1024] = Sv[2]; o[1536] = Sv[3]; }
    }
    SEAM(6);
    if (IN(7)) {
        for (int it = gt; it < 2 * 65536; it += NGT) {
            if (it < 65536) { const int s = it >> 9, c4 = it & 511; const size_t r0 = (size_t)s * 64;
                f32x4 h = {0.f, 0.f, 0.f, 0.f}, P = {1.f, 1.f, 1.f, 1.f};
                for (int t0 = 0; t0 < 64; t0 += 8) { f32x4 av[8], bv[8];
#pragma unroll
                    for (int t = 0; t < 8; ++t) { const u32x2 wa = ((const u32x2*)AA)[(r0 + t0 + t) * 512 + c4], wb = ((const u32x2*)BB)[(r0 + t0 + t) * 512 + c4];
                        av[t] = (f32x4){1.0f - bflo(wa.x), 1.0f - bfhi(wa.x), 1.0f - bflo(wa.y), 1.0f - bfhi(wa.y)}; bv[t] = (f32x4){bflo(wb.x), bfhi(wb.x), bflo(wb.y), bfhi(wb.y)}; }
#pragma unroll
                    for (int t = 0; t < 8; ++t) { h = av[t] * h + bv[t]; P = P * av[t];
                        ((u32x2*)HL)[(r0 + t0 + t) * 512 + c4] = (u32x2){pk2(h[0], h[1]), pk2(h[2], h[3])}; ((u32x2*)PC)[(r0 + t0 + t) * 512 + c4] = (u32x2){pk2(P[0], P[1]), pk2(P[2], P[3])}; } }
                ((f32x4*)AGA)[(size_t)s * 512 + c4] = P; ((f32x4*)AGB)[(size_t)s * 512 + c4] = h;
            } else { const int b = (it - 65536) >> 9, c4 = it & 511; const size_t r0 = (size_t)MP + b * 8;
                f32x4 h = ((const f32x4*)state_lru)[(size_t)b * 512 + c4];
                f32x4 av[8], bv[8]; u32x2 gv[8];
#pragma unroll
                for (int t = 0; t < 8; ++t) { const u32x2 wa = ((const u32x2*)AA)[(r0 + t) * 512 + c4], wb = ((const u32x2*)BB)[(r0 + t) * 512 + c4]; gv[t] = ((const u32x2*)GA)[(r0 + t) * 512 + c4];
                    av[t] = (f32x4){1.0f - bflo(wa.x), 1.0f - bfhi(wa.x), 1.0f - bflo(wa.y), 1.0f - bfhi(wa.y)}; bv[t] = (f32x4){bflo(wb.x), bfhi(wb.x), bflo(wb.y), bfhi(wb.y)}; }
#pragma unroll
                for (int t = 0; t < 8; ++t) { h = av[t] * h + bv[t]; const u32x2 gw2 = gv[t];
                    ((u32x2*)OA)[(r0 + t) * 512 + c4] = (u32x2){pk2(h[0] * bflo(gw2.x), h[1] * bfhi(gw2.x)), pk2(h[2] * bflo(gw2.y), h[3] * bfhi(gw2.y))}; }
                ((f32x4*)(out + O_LRUS))[(size_t)b * 512 + c4] = h; }
        }
        { OrderO S{(const char*)ACAT, (const char*)BCAT, G, bx, vcu}; EpiO E{OF}; pg8::gemm_phase(lds, 512, 512, S, E); }
    }
    SEAM(7);
    if (IN(8)) {
        for (int it = gt; it < 65536; it += NGT) { const int s = it >> 9, c4 = it & 511, b = s >> 5; const size_t r0 = (size_t)s * 64;
            f32x4 carry = {0.f, 0.f, 0.f, 0.f};
#pragma unroll 8
            for (int sp = b * 32; sp < s; ++sp) carry = ((const f32x4*)AGA)[(size_t)sp * 512 + c4] * carry + ((const f32x4*)AGB)[(size_t)sp * 512 + c4];
            f32x4 h = {0.f, 0.f, 0.f, 0.f};
            for (int t0 = 0; t0 < 64; t0 += 16) { u32x2 hv[16], pv[16], gv[16];
#pragma unroll
                for (int t = 0; t < 16; ++t) { hv[t] = ((const u32x2*)HL)[(r0 + t0 + t) * 512 + c4]; pv[t] = ((const u32x2*)PC)[(r0 + t0 + t) * 512 + c4]; gv[t] = ((const u32x2*)GA)[(r0 + t0 + t) * 512 + c4]; }
#pragma unroll
                for (int t = 0; t < 16; ++t) { const u32x2 hw = hv[t], pw = pv[t], gw2 = gv[t];
                    h = (f32x4){bflo(hw.x) + bflo(pw.x) * carry[0], bfhi(hw.x) + bfhi(pw.x) * carry[1], bflo(hw.y) + bflo(pw.y) * carry[2], bfhi(hw.y) + bfhi(pw.y) * carry[3]};
                    ((u32x2*)OA)[(r0 + t0 + t) * 512 + c4] = (u32x2){pk2(h[0] * bflo(gw2.x), h[1] * bfhi(gw2.x)), pk2(h[2] * bflo(gw2.y), h[3] * bfhi(gw2.y))}; } }
            if ((s & 31) == 31) ((f32x4*)(out + O_LRUP))[(size_t)b * 512 + c4] = h; }
        const bool bal8 = (G == 256); const bool hv8 = vcu < 128;
        const int n8 = bal8 ? (hv8 ? 2 : 14) : (MP * NH / 4 + NGW - 1 - gw) / NGW, w8 = bal8 ? ((hv8 ? vcu : vcu - 128) * NWAVES + wave) : gw, b8 = bal8 ? (hv8 ? 0 : 2048) : 0, s8 = bal8 ? 1024 : NGW;
        for (int q8 = 0; q8 < n8; ++q8) { const int wi0 = (b8 + w8 + q8 * s8) * 4;
            f32x4 v0[4], v1[4]; u32x2 s0[4], s1[4];
#pragma unroll
            for (int q2 = 0; q2 < 4; ++q2) { const int wi = wi0 + q2, row = wi >> 3, hh = wi & 7; const size_t base = (size_t)row * VD + hh * 512;
                const u32x2 o0 = ((const u32x2*)(OF + base))[lane], o1 = ((const u32x2*)(OF + base))[64 + lane];
                v0[q2] = (f32x4){bflo(o0.x), bfhi(o0.x), bflo(o0.y), bfhi(o0.y)}; v1[q2] = (f32x4){bflo(o1.x), bfhi(o1.x), bflo(o1.y), bfhi(o1.y)}; s0[q2] = ((const u32x2*)(SG + base))[lane]; s1[q2] = ((const u32x2*)(SG + base))[64 + lane]; }
#pragma unroll
            for (int q2 = 0; q2 < 4; ++q2) { const int wi = wi0 + q2, row = wi >> 3, hh = wi & 7; const size_t base = (size_t)row * VD + hh * 512;
                const f32x4 a0 = v0[q2], a1 = v1[q2];
                const float ss = (a0[0] * a0[0] + a0[1] * a0[1]) + (a0[2] * a0[2] + a0[3] * a0[3]) + (a1[0] * a1[0] + a1[1] * a1[1]) + (a1[2] * a1[2] + a1[3] * a1[3]);
                const float rstd = 1.0f / sqrtf(wave_sum(ss) * (1.0f / 512.0f) + EPS);
                const f32x4 g0 = ((const f32x4*)(ret_norm + hh * 512))[lane], g1 = ((const f32x4*)(ret_norm + hh * 512))[64 + lane];
                const float rs8 = rstd * O8_SCALE;
#define O8C(x) __builtin_amdgcn_fmed3f((x), -440.0f, 440.0f)
                ((unsigned*)((unsigned char*)OB + base))[lane] = f2fp8x4(O8C(a0[0] * rs8 * g0[0] * bflo(s0[q2].x)), O8C(a0[1] * rs8 * g0[1] * bfhi(s0[q2].x)), O8C(a0[2] * rs8 * g0[2] * bflo(s0[q2].y)), O8C(a0[3] * rs8 * g0[3] * bfhi(s0[q2].y)));
                ((unsigned*)((unsigned char*)OB + base))[64 + lane] = f2fp8x4(O8C(a1[0] * rs8 * g1[0] * bflo(s1[q2].x)), O8C(a1[1] * rs8 * g1[1] * bfhi(s1[q2].x)), O8C(a1[2] * rs8 * g1[2] * bflo(s1[q2].y)), O8C(a1[3] * rs8 * g1[3] * bfhi(s1[q2].y)));
#undef O8C
            } }
    }
    SEAM(8);
    if (IN(9)) {
        float* slabA = UT; float* slabB = (float*)((bf16*)UT + (size_t)8 * MS * D);
        { pg8::SplitOrder S; S.init(OA, (size_t)256 * D * 2, WPA, (size_t)256 * D * 2, D / 64, G, bx); EpiGate<0> E{SA, (bf16*)TMP, nullptr, slabA, 1.0f}; pg8::gemm_phase(lds, D, D, S, E); }
        { pg8::SplitOrder S; S.init(OB, (size_t)256 * VD, WPB, (size_t)256 * VD, VD / 128, G, bx); EpiGate<1> E{SB, (bf16*)TMP, MG, slabB, 1.0f / (O8_SCALE * W8_SCALE)};
          pg8::gemm_phase<EpiGate<1>, pg8::SplitOrder, 1>(lds, VD / 2, VD / 2, S, E); }
        xcd_barrier(bar);
        for (int q = gw; q < 2 * MS; q += NGW) { const int r = q >> 1, j0 = (q & 1) * 2; const size_t ro = (size_t)(MP + r) * D;
#pragma unroll 1
            for (int j = j0; j < j0 + 2; ++j) { const int c8 = lane + 64 * j;
                f32x4 a0 = {0.f, 0.f, 0.f, 0.f}, a1 = a0, b0 = a0, b1 = a0;
#pragma unroll
                for (int k = 0; k < 8; ++k) { const u32x4 wa = *(const u32x4*)((const bf16*)slabA + ((size_t)k * MS + r) * D + 8 * c8), wb = *(const u32x4*)((const bf16*)slabB + ((size_t)k * MS + r) * D + 8 * c8);
                    a0 += (f32x4){bflo(wa.x), bfhi(wa.x), bflo(wa.y), bfhi(wa.y)}; a1 += (f32x4){bflo(wa.z), bfhi(wa.z), bflo(wa.w), bfhi(wa.w)};
                    b0 += (f32x4){bflo(wb.x), bfhi(wb.x), bflo(wb.y), bfhi(wb.y)}; b1 += (f32x4){bflo(wb.z), bfhi(wb.z), bflo(wb.w), bfhi(wb.w)}; }
                const u32x4 ga = *(const u32x4*)(SA + ro + 8 * c8), gb = *(const u32x4*)(SB + ro + 8 * c8);
                u32x4 w;
                w.x = cvt_pk_bf16(bflo(ga.x) * a0[0] + bflo(gb.x) * b0[0], bfhi(ga.x) * a0[1] + bfhi(gb.x) * b0[1]);
                w.y = cvt_pk_bf16(bflo(ga.y) * a0[2] + bflo(gb.y) * b0[2], bfhi(ga.y) * a0[3] + bfhi(gb.y) * b0[3]);
                w.z = cvt_pk_bf16(bflo(ga.z) * a1[0] + bflo(gb.z) * b1[0], bfhi(ga.z) * a1[1] + bfhi(gb.z) * b1[1]);
                w.w = cvt_pk_bf16(bflo(ga.w) * a1[2] + bflo(gb.w) * b1[2], bfhi(ga.w) * a1[3] + bfhi(gb.w) * b1[3]);
                *(u32x4*)(MG + ro + 8 * c8) = w; } }
    }
    SEAM(9);
    if (IN(10)) { pg8::SplitOrder S; S.init(MG, (size_t)256 * D * 2, WOUT, (size_t)256 * D * 2, D / 64, G, bx); EpiResid<true> E{X, X, 1.0f, SLAB, 1.0f}; pg8::gemm_phase(lds, D, D, S, E); }
    SEAM(10);
    if (IN(11)) { for (int k_ = 0; k_ < rnk_; ++k_) { const int m = ROWMAP(k_); if (m < MP) rms_row_q8<true>(X + (size_t)m * D, ffn2_norm, U8 + (size_t)m * D, RS + m, lane);
            else rms_row_slab_q8<true>(X + (size_t)m * D, (const float*)((const bf16*)SLAB + (size_t)(m - MP) * D), 1.0f, X + (size_t)m * D, ffn2_norm, U8 + (size_t)m * D, RS + m, lane); } }
    SEAM(11);
    if (IN(12)) { pg8::TileOrder S; S.init(U8, (size_t)256 * D, W2A, (size_t)256 * D, 36, 44, D / 128, G, bx); EpiSwigluQ8 E{(unsigned char*)HB, RS, (const unsigned*)(ctl + CW_CM2)}; pg8::gemm_phase<EpiSwigluQ8, pg8::TileOrder, 2>(lds, D / 2, D / 2, S, E);
        if (bx >= 1584 - 6 * 256) { const int wk = (bx - (1584 - 6 * 256)) * NWAVES + wave, nwk = (G - (1584 - 6 * 256)) * NWAVES;
            convert(R_W2D0, R_WIN0, wk, nwk); convert(R_WPG0, R_LRU0, wk, nwk); } }
    SEAM(12);
    if (IN(13)) { pg8::SplitOrder S; S.init(HB, (size_t)256 * FF, W2D, (size_t)256 * FF, FF / 128, G, bx); EpiResid<true> E{X, X, 0.5f / (H8_SCALE * W8_SCALE), SLAB, 1.0f / (H8_SCALE * W8_SCALE)}; pg8::gemm_phase<EpiResid<true>, pg8::SplitOrder, 1>(lds, FF / 2, FF / 2, S, E); }
    SEAM(13);
    if (IN(14)) { for (int k_ = 0; k_ < rnk_; ++k_) { const int m = ROWMAP(k_); if (m < MP) rms_row_q8<true>(X + (size_t)m * D, ple_norm, U8 + (size_t)m * D, RS + m, lane);
            else rms_row_slab_q8<true>(X + (size_t)m * D, (const float*)((const bf16*)SLAB + (size_t)(m - MP) * D), 0.5f, X + (size_t)m * D, ple_norm, U8 + (size_t)m * D, RS + m, lane); } }
    SEAM(14);
    if (IN(15)) {
        { pg8::TileOrder S; S.init(PEB, (size_t)256 * PLE * 2, WPP, (size_t)256 * PLE * 2, 36, 8, PLE / 64, G, bx); EpiStoreF32 E{(bf16*)TMP2}; pg8::gemm_phase(lds, PLE, PLE, S, E); }
        { pg8::SplitOrder S; S.init(U8, (size_t)256 * D, WPG, (size_t)256 * D, D / 128, G, bx); EpiPle E{ple_bg, (const bf16*)TMP2, X, SLAB, RS, (const unsigned*)(ctl + CW_CM4)};
          pg8::gemm_phase<EpiPle, pg8::SplitOrder, 2>(lds, D / 2, D / 2, S, E); }
    }
    SEAM(15);
    if (IN(16)) { for (int k_ = 0; k_ < rnk_; ++k_) { const int m = ROWMAP(k_); if (m < MP) rms_row_f32(X + (size_t)m * D, final_norm, out + O_Y + (size_t)m * D, lane);
            else rms_row_ple_f32(X + (size_t)m * D, (const float*)((const bf16*)SLAB + (size_t)(m - MP) * D), ple_bg, (const bf16*)TMP2 + (size_t)m * D, final_norm, out + O_Y + (size_t)m * D, lane); } }
#undef IN
#undef SEAM
}

#undef x_prompt
#undef x_sample
#undef p_prompt
#undef p_sample
#undef state_lru
#undef state_conv
#undef state_ret
#undef ffn1_norm
#undef mix_norm
#undef b_in
#undef conv_w
#undef conv_b
#undef lru_ba
#undef lru_bx
#undef lru_lambda
#undef ret_norm
#undef ffn2_norm
#undef ple_norm
#undef ple_bg
#undef final_norm
#undef out
#undef W1A
#undef W1D
#undef W2A
#undef W2D
#undef WIN
#undef WPA
#undef WPB
#undef WOUT
#undef WPG
#undef WPP
#undef WLRU
#undef COS
#undef SIN
#undef U
#undef HB
#undef X
#undef XA
#undef SLAB
#undef GA
#undef Qb
#undef Kb
#undef ACAT
#undef BCAT
#undef KTD
#undef VTS
#undef SG
#undef SA
#undef SB
#undef XC
#undef AA
#undef BB
#undef HL
#undef PC
#undef AGA
#undef AGB
#undef OA
#undef UT
#undef OF
#undef OB
#undef TMP
#undef TMP2
#undef MG
#undef PEB
#undef ROWMAP
#undef U8
#undef WIN8
#undef RS
extern "C" void kernel_launch(void* const* d_in, const int* in_sizes, int n_in, void* d_out, int out_size, void* d_ws, size_t ws_size, hipStream_t stream) {
    static int grid = 0;
    if (grid == 0) {
        if (n_in != 34 || (size_t)out_size != O_END || ws_size < WS_END) { fprintf(stderr, "kernel_launch: unexpected shapes: n_in %d out %d ws %zu (need %zu)\n", n_in, out_size, ws_size, (size_t)WS_END); grid = -1; return; }
        int dev = 0, cus = 0, per_cu = 0;
        if (hipGetDevice(&dev) != hipSuccess || hipDeviceGetAttribute(&cus, hipDeviceAttributeMultiprocessorCount, dev) != hipSuccess) { grid = -1; return; }
        if (hipFuncSetAttribute((const void*)mega_fwd, hipFuncAttributeMaxDynamicSharedMemorySize, LDS_BYTES) != hipSuccess) { fprintf(stderr, "kernel_launch: hipFuncSetAttribute failed\n"); grid = -1; return; }
        if (hipOccupancyMaxActiveBlocksPerMultiprocessor(&per_cu, (const void*)mega_fwd, NWAVES * 64, LDS_BYTES) != hipSuccess || per_cu < 1) fprintf(stderr, "kernel_launch: occupancy query reports %d\n", per_cu);
        (void)hipGetLastError();
        grid = cus;
    }
    if (grid < 0) return;
    if (hipMemsetAsync((char*)d_ws + WS_CTL, 0, CTL_ZERO_BYTES, stream) != hipSuccess) return;
    Args a{};
    for (int i = 0; i < 34; ++i) a.in[i] = (const float*)d_in[i];
    a.out = (float*)d_out; a.ws = (unsigned char*)d_ws;
    a.ph_lo = 0; a.ph_hi = NPHASE;
    hipLaunchKernelGGL(mega_fwd, dim3(grid), dim3(NWAVES * 64), LDS_BYTES, stream, a);
}
```
